# Optimizing an MI355X kernel written in HIP

```python
import math
import jax, jax.numpy as jnp
from jax import lax
import numpy as np

D_MODEL = 1024
BATCH = 32
SEQ = 2048
DEPTH = 1

D_MIX = D_MODEL
D_HYENA = D_MIX // 2
HYENA_GROUPS = 8
D_ATTN = D_MIX - D_HYENA
N_HEADS = 8
HEAD_DIM = D_ATTN // N_HEADS
N_KV_HEADS = 2
Q_PER_KV = N_HEADS // N_KV_HEADS
KV_DIM = N_KV_HEADS * HEAD_DIM
WINDOW = 128
BLOCK = 128
SHORT_CONV = 3
FILTER_ORDER = 64
N_BANDS = 16
POS_EMB_DIM = 1 + 2 * N_BANDS
DECAY_TARGET = 1e-2
FAST_DECAY_PCT = 0.3
SLOW_DECAY_PCT = 1.5
RMS_EPS = 1e-6
NEG_INF = -1e30
D_IN = 3 * D_HYENA + D_HYENA + D_ATTN + 2 * KV_DIM + D_ATTN

kernel_name = "hybrid_hyena_swa_alibi_sandwich"


def rmsnorm(x, g):
    xf = x.astype(jnp.float32)
    xf = xf * lax.rsqrt(jnp.mean(xf * xf, axis=-1, keepdims=True) + RMS_EPS)
    return (xf * g.astype(jnp.float32)).astype(x.dtype)


def short_conv(u, w, b):
    L = u.shape[1]
    half = SHORT_CONV // 2
    up = jnp.pad(u, ((0, 0), (half, SHORT_CONV - 1 - half), (0, 0)))
    y = up[:, 0:L] * w[0]
    for j in range(1, SHORT_CONV):
        y = y + up[:, j:j + L] * w[j]
    return y + b


def hyena_filter(L, w_f1, b_f1, w_f2, b_f2, w_f3, b_f3, w_f4, sin_freq):
    f32 = jnp.float32
    t_np = np.arange(L, dtype=np.float32)
    t_norm_np = t_np / np.float32(max(L - 1, 1))
    w_np = np.float32(2.0 * math.pi) * t_np / np.float32(L)
    bands_np = np.linspace(1e-4, N_BANDS - 1, N_BANDS).astype(np.float32)
    ang_np = w_np[:, None] * bands_np[None, :]
    z = jnp.asarray(np.concatenate([t_norm_np[:, None], np.cos(ang_np), -np.sin(ang_np)], axis=-1))
    fr = sin_freq.astype(f32)
    h = jnp.sin(fr[0] * (z @ w_f1.astype(f32) + b_f1.astype(f32)))
    h = jnp.sin(fr[1] * (h @ w_f2.astype(f32) + b_f2.astype(f32)))
    h = jnp.sin(fr[2] * (h @ w_f3.astype(f32) + b_f3.astype(f32)))
    h = (h @ w_f4.astype(f32)).reshape(L, 2, D_HYENA)
    min_decay = math.log(DECAY_TARGET) / SLOW_DECAY_PCT
    max_decay = math.log(DECAY_TARGET) / FAST_DECAY_PCT
    deltas_np = np.abs(np.linspace(min_decay, max_decay, D_HYENA)).astype(np.float32)
    decay = jnp.asarray(np.exp(-t_norm_np[:, None] * deltas_np[None, :]).astype(np.float32))
    h = h * decay[:, None, :]
    h_fwd = h[:, 0, :]
    h_bwd = h[1:, 1, :]
    k = jnp.concatenate([h_fwd, jnp.zeros((1, D_HYENA), f32), h_bwd[::-1]], axis=0)
    return k * lax.rsqrt(jnp.sum(k * k, axis=0, keepdims=True) + 1e-12)


def hyena_mixer(u3, w_short, b_short, filt, hyena_d):
    L = u3.shape[1]
    uc = short_conv(u3, w_short, b_short)
    x0 = uc[..., :D_HYENA]
    x1 = uc[..., D_HYENA:2 * D_HYENA]
    v = uc[..., 2 * D_HYENA:]
    v = (v * x1).astype(jnp.float32)
    vf = jnp.fft.rfft(v, n=2 * L, axis=1)
    kf = jnp.fft.rfft(filt, axis=0)
    y = jnp.fft.irfft(vf * kf[None], n=2 * L, axis=1)[:, :L]
    y = (y + v * hyena_d.astype(jnp.float32)).astype(u3.dtype)
    return y * x0


def alibi_slopes_np():
    return np.exp2(-8.0 * np.arange(1, N_HEADS + 1, dtype=np.float32) / N_HEADS).astype(np.float32)


def windowed_attention(q, k, v, sink):
    B, L, _ = q.shape
    nb = L // BLOCK
    span = BLOCK + 2 * WINDOW
    scale = HEAD_DIM ** -0.5
    q5 = (q * scale).reshape(B, L, N_KV_HEADS, Q_PER_KV, HEAD_DIM)
    pad = ((0, 0), (WINDOW, WINDOW), (0, 0), (0, 0))
    k_pad = jnp.pad(k.reshape(B, L, N_KV_HEADS, HEAD_DIM), pad)
    v_pad = jnp.pad(v.reshape(B, L, N_KV_HEADS, HEAD_DIM), pad)
    slope = jnp.asarray(alibi_slopes_np().reshape(N_KV_HEADS, Q_PER_KV))
    sink_f = sink.astype(jnp.float32).reshape(N_KV_HEADS, Q_PER_KV)
    sk = sink_f[None, :, :, None]
    outs = []
    for i in range(nb):
        start = i * BLOCK
        qb = q5[:, start:start + BLOCK]
        kb = k_pad[:, start:start + span]
        vb = v_pad[:, start:start + span]
        q_pos = start + np.arange(BLOCK)
        k_pos = start - WINDOW + np.arange(span)
        rel_np = np.abs(k_pos[None, :] - q_pos[:, None])
        valid = jnp.asarray((rel_np <= WINDOW) & (k_pos >= 0)[None, :] & (k_pos < L)[None, :])
        rel = jnp.asarray(rel_np.astype(np.float32))
        s = jnp.einsum('bqkgd,bskd->bkgqs', qb, kb).astype(jnp.float32)
        s = s - slope[None, :, :, None, None] * rel
        s = jnp.where(valid, s, NEG_INF)
        m = jnp.maximum(jnp.max(s, axis=-1), sk)
        p = jnp.exp(s - m[..., None])
        den = jnp.sum(p, axis=-1) + jnp.exp(sk - m)
        o = jnp.einsum('bkgqs,bskd->bqkgd', p.astype(vb.dtype), vb)
        outs.append(o / jnp.transpose(den, (0, 3, 1, 2))[..., None].astype(o.dtype))
    out = jnp.concatenate(outs, axis=1)
    return out.reshape(B, L, D_ATTN)


def setup_inputs(seed: int = 0) -> dict:
    key = jax.random.key(seed)
    ks = jax.random.split(key, 20)
    nrm = jax.random.normal
    f32 = jnp.float32
    return {
        "x": nrm(ks[0], (BATCH, SEQ, D_MODEL), f32),
        "pre_g": 1.0 + 0.05 * nrm(ks[1], (DEPTH, D_MODEL), f32),
        "w_in": nrm(ks[2], (DEPTH, D_MODEL, D_IN), f32) * D_MODEL ** -0.5,
        "w_short": nrm(ks[3], (DEPTH, SHORT_CONV, 3 * D_HYENA), f32) * SHORT_CONV ** -0.5,
        "b_short": 0.02 * nrm(ks[4], (DEPTH, 3 * D_HYENA), f32),
        "w_f1": nrm(ks[5], (DEPTH, POS_EMB_DIM, FILTER_ORDER), f32) * POS_EMB_DIM ** -0.5,
        "b_f1": 0.1 * nrm(ks[6], (DEPTH, FILTER_ORDER), f32),
        "w_f2": nrm(ks[7], (DEPTH, FILTER_ORDER, FILTER_ORDER), f32) * FILTER_ORDER ** -0.5,
        "b_f2": 0.1 * nrm(ks[8], (DEPTH, FILTER_ORDER), f32),
        "w_f3": nrm(ks[9], (DEPTH, FILTER_ORDER, FILTER_ORDER), f32) * FILTER_ORDER ** -0.5,
        "b_f3": 0.1 * nrm(ks[10], (DEPTH, FILTER_ORDER), f32),
        "w_f4": nrm(ks[11], (DEPTH, FILTER_ORDER, 2 * D_HYENA), f32) * FILTER_ORDER ** -0.5,
        "sin_freq": 1.0 + 0.1 * nrm(ks[12], (DEPTH, 3, FILTER_ORDER), f32),
        "hyena_d": nrm(ks[13], (DEPTH, D_HYENA), f32),
        "attn_sink": 0.5 * nrm(ks[14], (DEPTH, N_HEADS), f32),
        "w_out": nrm(ks[15], (DEPTH, D_MIX, D_MODEL), f32) * D_MIX ** -0.5,
        "post_g": 1.0 + 0.05 * nrm(ks[16], (DEPTH, D_MODEL), f32),
    }


def reference(x, pre_g, w_in, w_short, b_short, w_f1, b_f1, w_f2, b_f2, w_f3, b_f3,
              w_f4, sin_freq, hyena_d, attn_sink, w_out, post_g):
    L = x.shape[1]
    o_hg = 3 * D_HYENA
    o_q = o_hg + D_HYENA
    o_k = o_q + D_ATTN
    o_v = o_k + KV_DIM
    o_ag = o_v + KV_DIM
    for l in range(DEPTH):
        h = rmsnorm(x, pre_g[l])
        z = h @ w_in[l]
        u_h, g_h = z[..., :o_hg], z[..., o_hg:o_q]
        q, k, v = z[..., o_q:o_k], z[..., o_k:o_v], z[..., o_v:o_ag]
        g_a = z[..., o_ag:]
        filt = hyena_filter(L, w_f1[l], b_f1[l], w_f2[l], b_f2[l], w_f3[l], b_f3[l],
                            w_f4[l], sin_freq[l])
        y_h = hyena_mixer(u_h, w_short[l], b_short[l], filt, hyena_d[l]) * jax.nn.silu(g_h)
        y_a = windowed_attention(q, k, v, attn_sink[l]) * jax.nn.silu(g_a)
        y = jnp.concatenate([y_h, y_a], axis=-1) @ w_out[l]
        x = x + rmsnorm(y, post_g[l])
    return x
```

```cpp
#include <hip/hip_runtime.h>
#include <hip/hip_cooperative_groups.h>
#include <cstdio>
#include <cstdint>
namespace cg = cooperative_groups;

#ifndef MK_N_LAUNCHES
#define MK_N_LAUNCHES 1
#endif

namespace pg8 {
#define PG8_LAS __attribute__((address_space(3)))
typedef unsigned short bf16_t;
typedef short bf16x8 __attribute__((ext_vector_type(8)));
typedef float f32x4 __attribute__((ext_vector_type(4)));
typedef unsigned u32x4 __attribute__((ext_vector_type(4)));
constexpr int BM = 256, BK = 64, HALF = 128, HTB = HALF * BK * 2  , STAGE_BYTES = 8 * HTB, NXCD = 8, WGM = 8;

__host__ __device__ __forceinline__ int lds_byte(int r, int c) { const int st = (r >> 4) * 2 + (c >> 5), rr = r & 15, cc = c & 31, ob = rr * 64 + cc * 2; return st * 1024 + (ob ^ (((ob >> 9) & 1) << 5)); }
__host__ __device__ __forceinline__ void stage_rc(int b, int& R, int& C) { const int st = b / 1024, sb = b % 1024, swz = sb ^ (((sb >> 9) & 1) << 5); R = (st >> 1) * 16 + swz / 64; C = (st & 1) * 32 + (swz % 64) / 2; }
__host__ __device__ __forceinline__ int perm32(int rho) { const int n = rho >> 4, i = rho & 15; return 8 * (i >> 2) + 4 * n + (i & 3); }

struct Unit { int pm, pn; };
struct Gemm { const bf16_t* A; const bf16_t* Bt; int M, N, K; };

struct StaticOrder {
    int nM, nN, nwg, G, c;
    __host__ __device__ void init(int M, int N, int G_, int c_) { nM = M / BM; nN = N / BM; nwg = nM * nN; G = G_; c = c_; }
    __host__ __device__ bool next(int i, Unit& u) const {
        const long L = (long)i * G + c; if (L >= nwg) return false;
        int wgid = (int)L; { const int q = nwg / NXCD, r = nwg % NXCD, xcd = wgid % NXCD, off = wgid / NXCD; wgid = (xcd < r ? xcd * (q + 1) : r * (q + 1) + (xcd - r) * q) + off; }
        const int nig = WGM * nN, gid = wgid / nig, fm = gid * WGM, gsz = (nM - fm) < WGM ? (nM - fm) : WGM;
        u.pm = fm + ((wgid % nig) % gsz); u.pn = (wgid % nig) / gsz; return true;
    }
    __device__ __forceinline__ void a_ready(const Unit&) const {}
    __device__ __forceinline__ void done(const Unit&) const {}
};
struct PanelOrder {
    int pm, ntn;
    __device__ bool next(int i, Unit& u) const { if (i >= ntn) return false; u.pm = pm; u.pn = i; return true; }
    __device__ __forceinline__ void a_ready(const Unit&) const {}
    __device__ __forceinline__ void done(const Unit&) const {}
};

typedef float f32x2 __attribute__((ext_vector_type(2))); typedef __bf16 bf16x2_t __attribute__((ext_vector_type(2)));
__device__ __forceinline__ unsigned cvt_pk_bf16(float lo, float hi) { f32x2 v = {lo, hi}; bf16x2_t b = __builtin_convertvector(v, bf16x2_t); return __builtin_bit_cast(unsigned, b); }
__device__ __forceinline__ float silu_f(float v) { return v * __builtin_amdgcn_rcpf(1.0f + __expf(-v)); }
__device__ __forceinline__ f32x4 silu4(f32x4 v) { return (f32x4){silu_f(v[0]), silu_f(v[1]), silu_f(v[2]), silu_f(v[3])}; }

struct EpiZT {
    static constexpr bool PERM = true, AFTER_DRAIN = false;
    bf16_t* O; int ldc;
    __device__ __forceinline__ void operator()(const f32x4 (&acc)[2][2][4][2], const Unit& u, int wr, int wc, int fr, int fq) const {
        const int row0 = u.pm * BM + wr * 64 + fr, col0 = u.pn * BM + wc * 32 + 8 * fq; const bool act = (u.pm >= 6);
#pragma unroll
        for (int ai = 0; ai < 2; ++ai)
#pragma unroll
            for (int m = 0; m < 4; ++m) { bf16_t* rowp = O + (size_t)(row0 + ai * HALF + m * 16) * ldc + col0;
#pragma unroll
                for (int bj = 0; bj < 2; ++bj) { f32x4 v0 = acc[ai][bj][m][0], v1 = acc[ai][bj][m][1];
                    if (act) { v0 = silu4(v0); v1 = silu4(v1); }
                    u32x4 w; w.x = cvt_pk_bf16(v0[0], v0[1]); w.y = cvt_pk_bf16(v0[2], v0[3]); w.z = cvt_pk_bf16(v1[0], v1[1]); w.w = cvt_pk_bf16(v1[2], v1[3]);
                    *(u32x4*)(rowp + bj * HALF) = w; } }
    }
};
struct EpiZA {
    static constexpr bool PERM = true, AFTER_DRAIN = false;
    bf16_t* O; int ldc; float qscale;
    __device__ __forceinline__ void operator()(const f32x4 (&acc)[2][2][4][2], const Unit& u, int wr, int wc, int fr, int fq) const {
        const int row0 = u.pm * BM + wr * 64 + fr, col0 = u.pn * BM + wc * 32 + 8 * fq; const bool act = (u.pn >= 3); const float sc = (u.pn < 2) ? qscale : 1.0f;
#pragma unroll
        for (int ai = 0; ai < 2; ++ai)
#pragma unroll
            for (int m = 0; m < 4; ++m) { bf16_t* rowp = O + (size_t)(row0 + ai * HALF + m * 16) * ldc + col0;
#pragma unroll
                for (int bj = 0; bj < 2; ++bj) { f32x4 v0 = acc[ai][bj][m][0], v1 = acc[ai][bj][m][1];
                    if (act) { v0 = silu4(v0); v1 = silu4(v1); }
                    v0 = v0 * sc; v1 = v1 * sc;
                    u32x4 w; w.x = cvt_pk_bf16(v0[0], v0[1]); w.y = cvt_pk_bf16(v0[2], v0[3]); w.z = cvt_pk_bf16(v1[0], v1[1]); w.w = cvt_pk_bf16(v1[2], v1[3]);
                    *(u32x4*)(rowp + bj * HALF) = w; } }
    }
};
struct EpiY {
    static constexpr bool PERM = true, AFTER_DRAIN = false;
    bf16_t* O; int ldc; float* SS;
    __device__ __forceinline__ void operator()(const f32x4 (&acc)[2][2][4][2], const Unit& u, int wr, int wc, int fr, int fq) const {
        const int row0 = u.pm * BM + wr * 64 + fr, col0 = u.pn * BM + wc * 32 + 8 * fq;
#pragma unroll
        for (int ai = 0; ai < 2; ++ai)
#pragma unroll
            for (int m = 0; m < 4; ++m) { const int row = row0 + ai * HALF + m * 16; bf16_t* rowp = O + (size_t)row * ldc + col0; float s = 0.f;
#pragma unroll
                for (int bj = 0; bj < 2; ++bj) { const f32x4 v0 = acc[ai][bj][m][0], v1 = acc[ai][bj][m][1];
                    s += (v0[0] * v0[0] + v0[1] * v0[1]) + (v0[2] * v0[2] + v0[3] * v0[3]) + (v1[0] * v1[0] + v1[1] * v1[1]) + (v1[2] * v1[2] + v1[3] * v1[3]);
                    u32x4 w; w.x = cvt_pk_bf16(v0[0], v0[1]); w.y = cvt_pk_bf16(v0[2], v0[3]); w.z = cvt_pk_bf16(v1[0], v1[1]); w.w = cvt_pk_bf16(v1[2], v1[3]);
                    *(u32x4*)(rowp + bj * HALF) = w; }
                s += __shfl_xor(s, 16); s += __shfl_xor(s, 32);
                if (fq == 0) SS[(size_t)row * 16 + u.pn * 4 + wc] = s;
                asm volatile("" ::: "memory"); }
    }
};

template <class Epi, class Sched, bool ALIGN_EPI = false, bool SP2 = false>
__device__ __forceinline__ void gemm_phase(PG8_LAS unsigned char* lds, const Gemm g, const Sched& S, const Epi& E) {
    int tid_l = threadIdx.x; asm volatile("" : "+v"(tid_l));
    const int tid = tid_l, wid = __builtin_amdgcn_readfirstlane(tid >> 6), lane = tid & 63, wr = wid >> 2, wc = wid & 3, fr = lane & 15, fq = lane >> 4;
    const int K = g.K, nt = K / BK;
    unsigned voffA[2], voffB[2];
#pragma unroll
    for (int i = 0; i < 2; ++i) { int R, C; stage_rc(tid * 16 + i * 8192, R, C); const int Rb = Epi::PERM ? ((R & ~31) + perm32(R & 31)) : R;
        voffA[i] = (unsigned)(R * K + C) * 2u; voffB[i] = (unsigned)(Rb * K + C) * 2u; }
    const size_t kstep = (size_t)(BK * 2);
    const size_t hstep = (size_t)HALF * K * 2;
    const size_t tstep = 2 * hstep;
    const unsigned ldsw = (unsigned)wid * 1024u;
    const int aoff = lds_byte(wr * 64 + fr, fq * 8), boff = lds_byte(wc * 32 + fr, fq * 8);
#define PG8_SA(b, h) (((b) * 2 + (h)) * HTB)
#define PG8_SB(b, h) ((4 + (b) * 2 + (h)) * HTB)
#define PG8_STAGE(bufoff, gbase, voff) do { _Pragma("unroll") for (int _i = 0; _i < 2; ++_i) \
        __builtin_amdgcn_global_load_lds((const unsigned*)((const char*)(gbase) + (voff)[_i]), (PG8_LAS unsigned*)(lds + (bufoff) + ldsw + _i * 8192), 16, 0, 0); } while (0)
#define PG8_LDA(dst, b, h) do { _Pragma("unroll") for (int m = 0; m < 4; ++m) _Pragma("unroll") for (int k = 0; k < 2; ++k) dst[m][k] = *(const PG8_LAS bf16x8*)(lds + PG8_SA(b, h) + aoff + m * 2048 + k * 1024); } while (0)
#define PG8_LDB(dst, b, h) do { _Pragma("unroll") for (int n = 0; n < 2; ++n) _Pragma("unroll") for (int k = 0; k < 2; ++k) dst[n][k] = *(const PG8_LAS bf16x8*)(lds + PG8_SB(b, h) + boff + n * 2048 + k * 1024); } while (0)
#define PG8_MMA(ai, bj, At, Bt) do { __builtin_amdgcn_s_setprio(1); _Pragma("unroll") for (int m = 0; m < 4; ++m) _Pragma("unroll") for (int n = 0; n < 2; ++n) _Pragma("unroll") for (int k = 0; k < 2; ++k) \
        acc[ai][bj][m][n] = __builtin_amdgcn_mfma_f32_16x16x32_bf16(Bt[n][k], At[m][k], acc[ai][bj][m][n], 0, 0, 0); __builtin_amdgcn_s_setprio(0); } while (0)
#define PG8_WAIT_V(n) asm volatile("s_waitcnt vmcnt(" #n ")" ::: "memory")
#define PG8_WAIT_L(n) asm volatile("s_waitcnt lgkmcnt(" #n ")" ::: "memory")
#define PG8_BAR __builtin_amdgcn_s_barrier()
#define PG8_SCHED __builtin_amdgcn_sched_barrier(0)
    Unit cur, nxt; int ui = 0;
    if (!S.next(0, cur)) return;
    f32x4 acc[2][2][4][2];
#pragma unroll
    for (int a = 0; a < 2; ++a)
#pragma unroll
        for (int b = 0; b < 2; ++b)
#pragma unroll
            for (int m = 0; m < 4; ++m)
#pragma unroll
                for (int n = 0; n < 2; ++n) acc[a][b][m][n] = (f32x4){0.f, 0.f, 0.f, 0.f};
    bf16x8 At[4][2], B0[2][2], B1[2][2];
    const char* cA = (const char*)g.A + (size_t)cur.pm * tstep; const char* cB = (const char*)g.Bt + (size_t)cur.pn * tstep;
    S.a_ready(cur);
    if constexpr (SP2) {
        PG8_STAGE(PG8_SB(0, 0), cB, voffB); PG8_STAGE(PG8_SB(0, 1), cB + hstep, voffB); PG8_STAGE(PG8_SA(0, 0), cA, voffA); PG8_STAGE(PG8_SA(0, 1), cA + hstep, voffA);
        if (wr == 1) PG8_BAR;
        PG8_WAIT_V(2); PG8_BAR;
        PG8_STAGE(PG8_SB(1, 0), cB + kstep, voffB); PG8_STAGE(PG8_SA(1, 0), cA + kstep, voffA); PG8_STAGE(PG8_SB(1, 1), cB + hstep + kstep, voffB);
        PG8_WAIT_V(6); PG8_BAR;
    } else {
        PG8_STAGE(PG8_SB(0, 0), cB, voffB); PG8_STAGE(PG8_SA(0, 0), cA, voffA); PG8_STAGE(PG8_SB(0, 1), cB + hstep, voffB); PG8_STAGE(PG8_SA(0, 1), cA + hstep, voffA);
        if (wr == 1) PG8_BAR;
        PG8_WAIT_V(4); PG8_BAR;
        PG8_STAGE(PG8_SB(1, 0), cB + kstep, voffB); PG8_STAGE(PG8_SA(1, 0), cA + kstep, voffA); PG8_STAGE(PG8_SB(1, 1), cB + hstep + kstep, voffB);
        PG8_WAIT_V(6); PG8_BAR;
    }
    for (;;) {
        const bool has_next = S.next(ui + 1, nxt);
        const char* nA = has_next ? (const char*)g.A + (size_t)nxt.pm * tstep : cA; const char* nB = has_next ? (const char*)g.Bt + (size_t)nxt.pn * tstep : cB;
        for (int t = 0; t < nt; t += 2) {
            const bool last = (t == nt - 2);
            const char* a1 = cA + (size_t)(t + 1) * kstep;
            const char* a2 = last ? nA : cA + (size_t)(t + 2) * kstep; const char* b2 = last ? nB : cB + (size_t)(t + 2) * kstep;
            const char* a3 = a2 + kstep; const char* b3 = b2 + kstep;
            if (last && has_next) S.a_ready(nxt);
            if constexpr (SP2) {
            PG8_LDB(B0, 0, 0); PG8_LDB(B1, 0, 1); PG8_SCHED; PG8_LDA(At, 0, 0); PG8_STAGE(PG8_SA(1, 1), a1 + hstep, voffA);
            PG8_WAIT_V(8); PG8_WAIT_L(0); PG8_BAR; PG8_MMA(0, 0, At, B0); PG8_MMA(0, 1, At, B1); PG8_BAR; PG8_SCHED;
            PG8_LDA(At, 0, 1); PG8_STAGE(PG8_SB(0, 0), b2, voffB); PG8_STAGE(PG8_SB(0, 1), b2 + hstep, voffB); PG8_STAGE(PG8_SA(0, 0), a2, voffA);
            PG8_WAIT_V(8); PG8_WAIT_L(0); PG8_BAR; PG8_MMA(1, 0, At, B0); PG8_MMA(1, 1, At, B1); PG8_BAR; PG8_SCHED;
            PG8_LDB(B0, 1, 0); PG8_LDB(B1, 1, 1); PG8_SCHED; PG8_LDA(At, 1, 0); PG8_STAGE(PG8_SA(0, 1), a2 + hstep, voffA);
            PG8_WAIT_V(8); PG8_WAIT_L(0); PG8_BAR; PG8_MMA(0, 0, At, B0); PG8_MMA(0, 1, At, B1); PG8_BAR; PG8_SCHED;
            PG8_LDA(At, 1, 1); PG8_STAGE(PG8_SB(1, 0), b3, voffB); PG8_STAGE(PG8_SB(1, 1), b3 + hstep, voffB); PG8_STAGE(PG8_SA(1, 0), a3, voffA);
            PG8_WAIT_V(8); PG8_WAIT_L(0); PG8_BAR; PG8_MMA(1, 0, At, B0); PG8_MMA(1, 1, At, B1); PG8_BAR; PG8_SCHED;
            } else {
            PG8_LDB(B0, 0, 0); PG8_SCHED; PG8_LDA(At, 0, 0); PG8_STAGE(PG8_SA(1, 1), a1 + hstep, voffA);
            PG8_WAIT_L(8); PG8_BAR; PG8_WAIT_L(0); PG8_MMA(0, 0, At, B0); PG8_BAR; PG8_SCHED;
            PG8_LDB(B1, 0, 1); PG8_STAGE(PG8_SB(0, 0), b2, voffB);
            PG8_BAR; PG8_WAIT_L(0); PG8_MMA(0, 1, At, B1); PG8_BAR;
            PG8_LDA(At, 0, 1); PG8_STAGE(PG8_SA(0, 0), a2, voffA);
            PG8_BAR; PG8_WAIT_L(0); PG8_MMA(1, 0, At, B0); PG8_BAR; PG8_SCHED;
            PG8_STAGE(PG8_SB(0, 1), b2 + hstep, voffB);
            PG8_WAIT_V(6); PG8_BAR; PG8_MMA(1, 1, At, B1); PG8_BAR;
            PG8_LDB(B0, 1, 0); PG8_SCHED; PG8_LDA(At, 1, 0); PG8_STAGE(PG8_SA(0, 1), a2 + hstep, voffA);
            PG8_WAIT_L(8); PG8_BAR; PG8_WAIT_L(0); PG8_MMA(0, 0, At, B0); PG8_BAR; PG8_SCHED;
            PG8_LDB(B1, 1, 1); PG8_STAGE(PG8_SB(1, 0), b3, voffB);
            PG8_BAR; PG8_WAIT_L(0); PG8_MMA(0, 1, At, B1); PG8_BAR;
            PG8_LDA(At, 1, 1); PG8_STAGE(PG8_SA(1, 0), a3, voffA);
            PG8_BAR; PG8_WAIT_L(0); PG8_MMA(1, 0, At, B0); PG8_BAR; PG8_SCHED;
            PG8_STAGE(PG8_SB(1, 1), b3 + hstep, voffB);
            PG8_WAIT_V(6); PG8_BAR; PG8_MMA(1, 1, At, B1); PG8_BAR;
            }
        }
        if constexpr (ALIGN_EPI) { if (wr == 0) PG8_BAR; }
        if constexpr (!Epi::AFTER_DRAIN) { E(acc, cur, wr, wc, fr, fq); S.done(cur); }
        if (!has_next) break;
#pragma unroll
        for (int a = 0; a < 2; ++a)
#pragma unroll
            for (int b = 0; b < 2; ++b)
#pragma unroll
                for (int m = 0; m < 4; ++m)
#pragma unroll
                    for (int n = 0; n < 2; ++n) acc[a][b][m][n] = (f32x4){0.f, 0.f, 0.f, 0.f};
        cur = nxt; cA = nA; cB = nB; ++ui;
        if constexpr (ALIGN_EPI) { if (wr == 1) PG8_BAR; }
    }
    PG8_WAIT_V(0);
    if constexpr (!ALIGN_EPI) { if (wr == 0) PG8_BAR; }
    PG8_BAR;
    if constexpr (Epi::AFTER_DRAIN) { E.fused(acc, cur, wr, wc, fr, fq, lds, wid, lane); S.done(cur); }
#undef PG8_SA
#undef PG8_SB
#undef PG8_STAGE
#undef PG8_LDA
#undef PG8_LDB
#undef PG8_MMA
#undef PG8_WAIT_V
#undef PG8_WAIT_L
#undef PG8_BAR
#undef PG8_SCHED
}
}

constexpr int NWAVES = 8, NTHREADS = 512;
constexpr int BATCH = 32, SEQ = 2048, DMODEL = 1024, MTOK = BATCH * SEQ;
constexpr int DHY = 512, NHYC = 2048  , NATC = 1280  , NIN = 3328;
constexpr int NHEADS = 8, HD = 64, WIN = 128;
constexpr float RMS_EPS = 1e-6f, LOG2E = 1.4426950408889634f;
constexpr float QSCALE = 0.125f * LOG2E;

constexpr size_t MiB = 1u << 20;
constexpr size_t WS_W1T = 2 * MiB;
constexpr size_t WS_W2T = 10 * MiB;
constexpr size_t WS_FRAW = 12 * MiB;
constexpr size_t WS_SS = 20 * MiB;
constexpr size_t WS_XN = 32 * MiB;
constexpr size_t WS_ZT = 160 * MiB;
constexpr size_t WS_ZA = 416 * MiB;
constexpr size_t WS_YT = 576 * MiB;
constexpr size_t WS_YMIX = 640 * MiB;
constexpr size_t WS_YRAW = 768 * MiB;
constexpr size_t WS_END = 896 * MiB;

constexpr int LDS_BYTES = 147456;

#define LAS __attribute__((address_space(3)))
typedef unsigned short bf16;
typedef unsigned v4u __attribute__((ext_vector_type(4)));
typedef unsigned v2u __attribute__((ext_vector_type(2)));
typedef float f32x4 __attribute__((ext_vector_type(4)));
typedef float f32x16 __attribute__((ext_vector_type(16)));
typedef short bf16x8 __attribute__((ext_vector_type(8)));
typedef short s16x4 __attribute__((ext_vector_type(4)));
#define LDS_WAIT() asm volatile("s_waitcnt lgkmcnt(0)" ::: "memory")
#define VM_WAIT() asm volatile("s_waitcnt vmcnt(0)" ::: "memory")
__device__ __forceinline__ unsigned f2bf(float f) { unsigned u = __builtin_bit_cast(unsigned, f); return (u + 0x7fffu + ((u >> 16) & 1u)) >> 16; }
__device__ __forceinline__ unsigned pk2(float lo, float hi) { return pg8::cvt_pk_bf16(lo, hi); }
__device__ __forceinline__ float bf2f(unsigned u16) { return __uint_as_float(u16 << 16); }
__device__ __forceinline__ float bflo(unsigned w) { return __uint_as_float(w << 16); }
__device__ __forceinline__ float bfhi(unsigned w) { return __uint_as_float(w & 0xffff0000u); }
__device__ __forceinline__ int crow(int r, int hi) { return (r & 3) + 8 * (r >> 2) + 4 * hi; }
__device__ __forceinline__ float wave_sum(float v) {
#pragma unroll
    for (int o = 1; o < 64; o <<= 1) v += __shfl_xor(v, o);
    return v;
}

struct Args { const float* in[17]; float* out; unsigned char* ws; int ph_lo, ph_hi; };
struct Frame {
    LAS unsigned char* lds;
    int tid, lane, wave, vcu, G;
    const Args* A;
#define FRAME_IN(name, k) __device__ __forceinline__ const float* name() const { return A->in[k]; }
    FRAME_IN(x, 0) FRAME_IN(pre_g, 1) FRAME_IN(w_in, 2) FRAME_IN(w_short, 3) FRAME_IN(b_short, 4) FRAME_IN(w_f1, 5) FRAME_IN(b_f1, 6) FRAME_IN(w_f2, 7) FRAME_IN(b_f2, 8)
    FRAME_IN(w_f3, 9) FRAME_IN(b_f3, 10) FRAME_IN(w_f4, 11) FRAME_IN(sin_freq, 12) FRAME_IN(hyena_d, 13) FRAME_IN(attn_sink, 14) FRAME_IN(w_out, 15) FRAME_IN(post_g, 16)
#undef FRAME_IN
    __device__ __forceinline__ float* out() const { return A->out; }
#define FRAME_WS(type, name, off) __device__ __forceinline__ type* name() const { return (type*)(A->ws + (off)); }
    FRAME_WS(bf16, W1T, WS_W1T) FRAME_WS(bf16, W2T, WS_W2T) FRAME_WS(float, FRAW, WS_FRAW) FRAME_WS(float, SS, WS_SS) FRAME_WS(bf16, XN, WS_XN)
    FRAME_WS(bf16, ZT, WS_ZT) FRAME_WS(bf16, ZA, WS_ZA) FRAME_WS(bf16, YT, WS_YT) FRAME_WS(bf16, YMIX, WS_YMIX) FRAME_WS(bf16, YRAW, WS_YRAW)
#undef FRAME_WS
};

__device__ __forceinline__ float sin_rev(float x) { const float rv = x * 0.15915494309189535f; return __builtin_amdgcn_sinf(rv - floorf(rv)); }
__device__ __forceinline__ float cos_rev(float x) { const float rv = x * 0.15915494309189535f; return __builtin_amdgcn_cosf(rv - floorf(rv)); }
__device__ __forceinline__ void p0_transpose_item(const float* W, int K, int N, bf16* WT, const float* gk, LAS float* scr, int item, int lane) {
    const int nblk = N / 32, kb = item / nblk, nb = item % nblk, k0 = 64 * kb, n0 = 32 * nb;
#pragma unroll 8
    for (int i = 0; i < 32; ++i) { const int kk = 2 * i + (lane >> 5); scr[kk * 33 + (lane & 31)] = W[(size_t)(k0 + kk) * N + n0 + (lane & 31)]; }
    LDS_WAIT(); asm volatile("" ::: "memory");
    const int c = lane & 7;
    float g8[8];
#pragma unroll
    for (int i = 0; i < 8; ++i) g8[i] = gk ? gk[k0 + 8 * c + i] : 1.0f;
#pragma unroll
    for (int j = 0; j < 4; ++j) { const int n = (lane >> 3) + 8 * j; const LAS float* s = scr + (8 * c) * 33 + n;
        v4u o; o.x = pk2(s[0 * 33] * g8[0], s[1 * 33] * g8[1]); o.y = pk2(s[2 * 33] * g8[2], s[3 * 33] * g8[3]); o.z = pk2(s[4 * 33] * g8[4], s[5 * 33] * g8[5]); o.w = pk2(s[6 * 33] * g8[6], s[7 * 33] * g8[7]);
        *(v4u*)(WT + (size_t)(n0 + n) * K + k0 + 8 * c) = o; }
    LDS_WAIT(); asm volatile("" ::: "memory");
}
__device__ __forceinline__ void rms_row_to_bf16(const float* xrow, bf16* orow, int lane) {
    const f32x4* xr = (const f32x4*)xrow + lane;
    f32x4 v[4]; float s = 0.f;
#pragma unroll
    for (int j = 0; j < 4; ++j) { v[j] = xr[64 * j]; s += (v[j].x * v[j].x + v[j].y * v[j].y) + (v[j].z * v[j].z + v[j].w * v[j].w); }
    const float rstd = 1.0f / sqrtf(wave_sum(s) * (1.0f / DMODEL) + RMS_EPS);
    v2u* o8 = (v2u*)orow + lane;
#pragma unroll
    for (int j = 0; j < 4; ++j) { v2u w; w.x = pk2(v[j].x * rstd, v[j].y * rstd); w.y = pk2(v[j].z * rstd, v[j].w * rstd); o8[64 * j] = w; }
}
__device__ __forceinline__ void p0_filter_item(Frame& F, int item) {
    const int lane = F.lane, wave = F.wave, t = 8 * item + wave;
    LAS float* zs = (LAS float*)(F.lds + wave * 16384);
    LAS float* fo = (LAS float*)(F.lds + wave * 16384 + 4096);
    const float tn = (float)t / 2047.0f;
    const float w = (6.2831855f * (float)t) / 2048.0f;
    {
        float z = 0.f;
        if (lane == 0) z = tn;
        else if (lane <= 32) {
            const int i = (lane - 1) & 15;
            const float band = (float)(1e-4 + (double)i * ((15.0 - 1e-4) / 15.0));
            const float ang = w * band;
            z = (lane <= 16) ? cos_rev(ang) : -sin_rev(ang);
        }
        zs[lane] = z;
    }
    __syncthreads();
    {
        float a = 0.f;
#pragma unroll 3
        for (int k = 0; k < 33; ++k) a += zs[k] * F.w_f1()[k * 64 + lane];
        a += F.b_f1()[lane];
        zs[64 + lane] = sin_rev(F.sin_freq()[lane] * a);
    }
    __syncthreads();
    {
        float a = 0.f;
#pragma unroll 4
        for (int k = 0; k < 64; ++k) a += zs[64 + k] * F.w_f2()[k * 64 + lane];
        a += F.b_f2()[lane];
        zs[128 + lane] = sin_rev(F.sin_freq()[64 + lane] * a);
    }
    __syncthreads();
    {
        float a = 0.f;
#pragma unroll 4
        for (int k = 0; k < 64; ++k) a += zs[128 + k] * F.w_f3()[k * 64 + lane];
        a += F.b_f3()[lane];
        zs[192 + lane] = sin_rev(F.sin_freq()[128 + lane] * a);
    }
    __syncthreads();
    {
        float a[16];
#pragma unroll
        for (int j = 0; j < 16; ++j) a[j] = 0.f;
#pragma unroll 2
        for (int k = 0; k < 64; ++k) { const float hk = zs[192 + k]; const float* wr = F.w_f4() + (size_t)k * 1024 + lane;
#pragma unroll
            for (int j = 0; j < 16; ++j) a[j] += hk * wr[64 * j]; }
        const double min_decay = -4.605170185988091 / 1.5, max_decay = -4.605170185988091 / 0.3;
#pragma unroll
        for (int j = 0; j < 16; ++j) { const int col = lane + 64 * j, c = col & 511;
            double dl = min_decay + (double)c * ((max_decay - min_decay) / 511.0); if (c == 511) dl = max_decay;
            const float delta = (float)(dl < 0 ? -dl : dl);
            fo[col] = a[j] * expf(-(tn * delta)); }
    }
    __syncthreads();
    {
        const int tid = F.tid;
#pragma unroll
        for (int cc = 0; cc < 2; ++cc) { const int col = tid + 512 * cc; float v[8];
#pragma unroll
            for (int p = 0; p < 8; ++p) v[p] = *(const LAS float*)(F.lds + p * 16384 + 4096 + col * 4);
            f32x4* dst = (f32x4*)(F.FRAW() + (size_t)col * SEQ + 8 * item);
            dst[0] = (f32x4){v[0], v[1], v[2], v[3]}; dst[1] = (f32x4){v[4], v[5], v[6], v[7]}; }
    }
    __syncthreads();
}
__device__ __forceinline__ void p0_prologue(Frame& F) {
    LAS float* scr = (LAS float*)(F.lds + F.wave * 16384);
    const int gw = F.vcu * NWAVES + F.wave, NGW = F.G * NWAVES;
    constexpr int I1 = (DMODEL / 64) * (NIN / 32), I2 = (DMODEL / 64) * (DMODEL / 32);
    for (int it = gw; it < I1 + I2; it += NGW) {
        if (it < I1) p0_transpose_item(F.w_in(), DMODEL, NIN, F.W1T(), F.pre_g(), scr, it, F.lane);
        else p0_transpose_item(F.w_out(), DMODEL, DMODEL, F.W2T(), nullptr, scr, it - I1, F.lane);
    }
    for (int m = gw; m < MTOK; m += NGW) rms_row_to_bf16(F.x() + (size_t)m * DMODEL, F.XN() + (size_t)m * DMODEL, F.lane);
    __syncthreads();
    for (int it = F.vcu; it < SEQ / 8; it += F.G) p0_filter_item(F, it);
}

constexpr int HY_CS = 8256;
constexpr int HY_TBL = 0, HY_VB = 8 * HY_CS;
constexpr int HY_VSTR = 2064;
constexpr int HY_SCW = 32 * 132 * 4;
static_assert(HY_VB + 32 * HY_VSTR <= LDS_BYTES && 8 * HY_SCW <= LDS_BYTES, "hyena LDS map");

__device__ __forceinline__ void conv8(float (&o)[8], const v4u c, float left, float right, float w0, float w1, float w2, float bias) {
    float e[10]; e[0] = left; e[9] = right;
    e[1] = bflo(c.x); e[2] = bfhi(c.x); e[3] = bflo(c.y); e[4] = bfhi(c.y); e[5] = bflo(c.z); e[6] = bfhi(c.z); e[7] = bflo(c.w); e[8] = bfhi(c.w);
#pragma unroll
    for (int j = 0; j < 8; ++j) o[j] = ((e[j] * w0 + e[j + 1] * w1) + e[j + 2] * w2) + bias;
}

__device__ __forceinline__ void hyena_unit(Frame& F, int c) {
    int tid = F.tid; asm volatile("" : "+v"(tid));
    const int lane = tid & 63, wave = F.wave, r = lane & 31, h = lane >> 5;
    LAS unsigned char* lds = F.lds;
    __syncthreads();
    {
        const float* ff = F.FRAW() + (size_t)c * SEQ; const float* fb = F.FRAW() + (size_t)(DHY + c) * SEQ;
        float rv[8]; float ssq = 0.f;
#pragma unroll
        for (int j = 0; j < 8; ++j) { const int n = tid + 512 * j; float v = 0.f;
            if (n <= 2047) v = ff[2047 - n]; else if (n <= 4094) v = fb[n - 2047];
            rv[j] = v; ssq += v * v; }
        ssq = wave_sum(ssq);
        LAS float* red = (LAS float*)(lds + HY_VB);
        if (lane == 0) red[wave] = ssq;
        __syncthreads();
        float tot = 0.f;
#pragma unroll
        for (int i = 0; i < 8; ++i) tot += red[i];
        const float scale = 1.0f / sqrtf(tot + 1e-12f);
#pragma unroll
        for (int j = 0; j < 8; ++j) { const int n = tid + 512 * j; const unsigned short bfv = (unsigned short)f2bf(rv[j] * scale);
#pragma unroll
            for (int q = 0; q < 8; ++q) { const int m = n - q; if (m >= 0) *(LAS unsigned short*)(lds + HY_TBL + q * HY_CS + 2 * m) = bfv; } }
    }
    const float wx0_0 = F.w_short()[c], wx0_1 = F.w_short()[1536 + c], wx0_2 = F.w_short()[3072 + c], bx0 = F.b_short()[c];
    const float wx1_0 = F.w_short()[DHY + c], wx1_1 = F.w_short()[1536 + DHY + c], wx1_2 = F.w_short()[3072 + DHY + c], bx1 = F.b_short()[DHY + c];
    const float wv_0 = F.w_short()[2 * DHY + c], wv_1 = F.w_short()[1536 + 2 * DHY + c], wv_2 = F.w_short()[3072 + 2 * DHY + c], bv = F.b_short()[2 * DHY + c];
    const float dskip = F.hyena_d()[c];
    const bf16* x0row = F.ZT() + (size_t)c * MTOK; const bf16* x1row = F.ZT() + (size_t)(DHY + c) * MTOK;
    const bf16* vrow = F.ZT() + (size_t)(2 * DHY + c) * MTOK; const bf16* grow = F.ZT() + (size_t)(3 * DHY + c) * MTOK;

    f32x16 acc[8];
#pragma unroll
    for (int i = 0; i < 8; ++i) acc[i] = f32x16{};
    bf16x8 fr[16];
    const int q = 7 - (r & 7);
    const int abase = HY_TBL + q * HY_CS + 4080 - 16 * (r >> 3) + 16 * h;
    const int bbase = HY_VB + r * HY_VSTR + 16 * h;
#define HY_LDA(a) (*(const LAS bf16x8*)(lds + abase - 32 * (a)))
#pragma unroll 1
    for (int ch = 0; ch < 2; ++ch) {
        __syncthreads();
#pragma unroll 1
        for (int it = 0; it < 8; ++it) {
            const int idx = it * 512 + tid, b = idx >> 7, sg = idx & 127, s = ch * 1024 + 8 * sg;
            const bf16* p1 = x1row + b * SEQ + s; const bf16* pv = vrow + b * SEQ + s;
            const v4u c1 = *(const v4u*)p1, cv = *(const v4u*)pv;
            const float l1 = (s > 0) ? bf2f(p1[-1]) : 0.f, r1 = (s + 8 < SEQ) ? bf2f(p1[8]) : 0.f;
            const float lv = (s > 0) ? bf2f(pv[-1]) : 0.f, rv_ = (s + 8 < SEQ) ? bf2f(pv[8]) : 0.f;
            float o1[8], ov[8];
            conv8(o1, c1, l1, r1, wx1_0, wx1_1, wx1_2, bx1);
            conv8(ov, cv, lv, rv_, wv_0, wv_1, wv_2, bv);
            v4u w; w.x = pk2(ov[0] * o1[0], ov[1] * o1[1]); w.y = pk2(ov[2] * o1[2], ov[3] * o1[3]); w.z = pk2(ov[4] * o1[4], ov[5] * o1[5]); w.w = pk2(ov[6] * o1[6], ov[7] * o1[7]);
            *(LAS v4u*)(lds + HY_VB + b * HY_VSTR + sg * 16) = w;
        }
        __syncthreads();
        {
#pragma unroll
            for (int s_ = 0; s_ < 15; ++s_) fr[s_] = HY_LDA(16 * wave - 64 * ch + s_);
            fr[15] = HY_LDA(16 * wave - 64 * ch - 1);
        }
#pragma unroll 1
        for (int body = 0; body < 4; ++body) {
            const int kl0 = body * 16, kg0 = ch * 64 + kl0;
#pragma unroll
            for (int kk = 0; kk < 16; ++kk) {
                const bf16x8 bfrag = *(const LAS bf16x8*)(lds + bbase + 32 * (kl0 + kk));
#pragma unroll
                for (int i = 0; i < 8; ++i) acc[i] = __builtin_amdgcn_mfma_f32_32x32x16_bf16(fr[(2 * i - kk) & 15], bfrag, acc[i], 0, 0, 0);
                fr[(14 - kk) & 15] = HY_LDA(16 * wave - 2 - (kg0 + kk));
            }
        }
    }
#undef HY_LDA
    __syncthreads();
    LAS float* sc = (LAS float*)(lds + wave * HY_SCW);
#pragma unroll
    for (int hh = 0; hh < 2; ++hh) {
#pragma unroll
        for (int ii = 0; ii < 4; ++ii)
#pragma unroll
            for (int rr = 0; rr < 16; ++rr) sc[r * 132 + 32 * ii + crow(rr, h)] = acc[4 * hh + ii][rr];
        LDS_WAIT(); asm volatile("" ::: "memory");
#pragma unroll 1
        for (int it = 0; it < 8; ++it) {
            const int b = 4 * it + (lane >> 4), tg = lane & 15, t = 256 * wave + 128 * hh + 8 * tg;
            const f32x4 y0 = *(const LAS f32x4*)(sc + b * 132 + 8 * tg), y1 = *(const LAS f32x4*)(sc + b * 132 + 8 * tg + 4);
            const size_t off = (size_t)b * SEQ + t;
            const bf16* p0 = x0row + off; const bf16* p1 = x1row + off; const bf16* pv = vrow + off;
            const v4u c0 = *(const v4u*)p0, c1 = *(const v4u*)p1, cv = *(const v4u*)pv, cg_ = *(const v4u*)(grow + off);
            const bool hasl = t > 0, hasr = (t + 8 < SEQ);
            const float l0 = hasl ? bf2f(p0[-1]) : 0.f, r0 = hasr ? bf2f(p0[8]) : 0.f;
            const float l1 = hasl ? bf2f(p1[-1]) : 0.f, r1 = hasr ? bf2f(p1[8]) : 0.f;
            const float lv = hasl ? bf2f(pv[-1]) : 0.f, rv_ = hasr ? bf2f(pv[8]) : 0.f;
            float o0[8], o1[8], ov[8];
            conv8(o0, c0, l0, r0, wx0_0, wx0_1, wx0_2, bx0);
            conv8(o1, c1, l1, r1, wx1_0, wx1_1, wx1_2, bx1);
            conv8(ov, cv, lv, rv_, wv_0, wv_1, wv_2, bv);
            const float yv[8] = {y0[0], y0[1], y0[2], y0[3], y1[0], y1[1], y1[2], y1[3]};
            const float gt[8] = {bflo(cg_.x), bfhi(cg_.x), bflo(cg_.y), bfhi(cg_.y), bflo(cg_.z), bfhi(cg_.z), bflo(cg_.w), bfhi(cg_.w)};
            float res[8];
#pragma unroll
            for (int j = 0; j < 8; ++j) { const float vv = ov[j] * o1[j]; res[j] = ((yv[j] + vv * dskip) * o0[j]) * gt[j]; }
            v4u w; w.x = pk2(res[0], res[1]); w.y = pk2(res[2], res[3]); w.z = pk2(res[4], res[5]); w.w = pk2(res[6], res[7]);
            *(v4u*)(F.YT() + (size_t)c * MTOK + off) = w;
        }
        LDS_WAIT(); asm volatile("" ::: "memory");
    }
}

constexpr int AT_KSTR = 144, AT_VSTR = 192, AT_ROWS = 320;
constexpr int AT_KS = 0, AT_VS = AT_ROWS * AT_KSTR  , AT_SCR = AT_VS + AT_ROWS * AT_VSTR  ;
static_assert(AT_SCR + 8 * 128 <= LDS_BYTES, "attention LDS map");

__device__ __forceinline__ s16x4 lds_tr(const LAS unsigned char* p) {
    typedef short v4i16_t __attribute__((ext_vector_type(4)));
    return __builtin_bit_cast(s16x4, __builtin_amdgcn_ds_read_tr16_b64_v4i16((LAS v4i16_t*)p));
}

__device__ __forceinline__ void attn_unit(Frame& F, int uidx) {
    int tid = F.tid; asm volatile("" : "+v"(tid));
    const int lane = tid & 63, wave = F.wave, r = lane & 31, h = lane >> 5;
    LAS unsigned char* lds = F.lds;
    const int qb = uidx & 31, kvh = (uidx >> 5) & 1, b = uidx >> 6;
    const int q0 = qb * 64, kbase = q0 - WIN; const size_t rowbase = (size_t)b * SEQ;
    __syncthreads();
    for (int p = tid; p < AT_ROWS * 8; p += NTHREADS) {
        const int row = p >> 3, pc = p & 7, key = kbase + row;
        v4u kk = (v4u){0u, 0u, 0u, 0u}, vv = (v4u){0u, 0u, 0u, 0u};
        if (key >= 0 && key < SEQ) { const bf16* src = F.ZA() + (rowbase + key) * NATC + 512 + 64 * kvh + 8 * pc; kk = *(const v4u*)src; vv = *(const v4u*)(src + 128); }
        *(LAS v4u*)(lds + AT_KS + row * AT_KSTR + pc * 16) = kk;
        *(LAS v4u*)(lds + AT_VS + row * AT_VSTR + pc * 16) = vv;
    }
    __syncthreads();
    const int g = wave >> 1, sub = wave & 1, hd = 4 * kvh + g, qs = q0 + 32 * sub;
    bf16x8 qf[4];
    { const bf16* qp = F.ZA() + (rowbase + qs + r) * NATC + 64 * hd + 8 * h;
#pragma unroll
      for (int d = 0; d < 4; ++d) qf[d] = *(const bf16x8*)(qp + 16 * d); }
    const float slope2 = exp2f(-(float)(hd + 1)) * LOG2E, sink2 = F.attn_sink()[hd] * LOG2E;
    const LAS unsigned char* kp = lds + AT_KS + (32 * sub + r) * AT_KSTR + 16 * h;
    const LAS unsigned char* vp = lds + AT_VS + (32 * sub + 4 * h + ((lane & 15) >> 2)) * AT_VSTR + (16 * ((lane >> 4) & 1) + 4 * (lane & 3)) * 2;
#define AT_SCORES(S, j) do { S = f32x16{}; \
        _Pragma("unroll") for (int d = 0; d < 4; ++d) { const bf16x8 kf = *(const LAS bf16x8*)(kp + (j) * 32 * AT_KSTR + d * 32); S = __builtin_amdgcn_mfma_f32_32x32x16_bf16(kf, qf[d], S, 0, 0, 0); } \
        _Pragma("unroll") for (int rr = 0; rr < 16; ++rr) { const int rel = 32 * (j) - WIN + crow(rr, h) - r; const int kpos = qs + r + rel; const int arel = rel < 0 ? -rel : rel; \
            const bool ok = (arel <= WIN) && (kpos >= 0) && (kpos < SEQ); S[rr] = ok ? (S[rr] - slope2 * (float)arel) : -1e30f; } } while (0)
    float mx = sink2;
#pragma unroll 1
    for (int j = 0; j < 9; ++j) { f32x16 S; AT_SCORES(S, j);
#pragma unroll
        for (int rr = 0; rr < 16; ++rr) mx = fmaxf(mx, S[rr]); }
    mx = fmaxf(mx, __shfl_xor(mx, 32));
    float lsum = 0.f; f32x16 o0 = f32x16{}, o1 = f32x16{};
#pragma unroll 1
    for (int j = 0; j < 9; ++j) { f32x16 S; AT_SCORES(S, j);
#pragma unroll
        for (int rr = 0; rr < 16; ++rr) { const float pexp = (S[rr] > -1e29f) ? exp2f(S[rr] - mx) : 0.f; S[rr] = pexp; lsum += pexp; }
#pragma unroll
        for (int ks = 0; ks < 2; ++ks) {
            v4u pw; pw.x = pk2(S[8 * ks + 0], S[8 * ks + 1]); pw.y = pk2(S[8 * ks + 2], S[8 * ks + 3]); pw.z = pk2(S[8 * ks + 4], S[8 * ks + 5]); pw.w = pk2(S[8 * ks + 6], S[8 * ks + 7]);
            const bf16x8 pf = __builtin_bit_cast(bf16x8, pw);
            const LAS unsigned char* vb = vp + (j * 32 + 16 * ks) * AT_VSTR;
            { const s16x4 lo = lds_tr(vb), hi4 = lds_tr(vb + 8 * AT_VSTR);
              const bf16x8 vf = (bf16x8){lo[0], lo[1], lo[2], lo[3], hi4[0], hi4[1], hi4[2], hi4[3]};
              o0 = __builtin_amdgcn_mfma_f32_32x32x16_bf16(pf, vf, o0, 0, 0, 0); }
            { const s16x4 lo = lds_tr(vb + 64), hi4 = lds_tr(vb + 64 + 8 * AT_VSTR);
              const bf16x8 vf = (bf16x8){lo[0], lo[1], lo[2], lo[3], hi4[0], hi4[1], hi4[2], hi4[3]};
              o1 = __builtin_amdgcn_mfma_f32_32x32x16_bf16(pf, vf, o1, 0, 0, 0); }
        }
    }
#undef AT_SCORES
    lsum += __shfl_xor(lsum, 32);
    lsum += exp2f(sink2 - mx);
    LAS float* wsf = (LAS float*)(lds + AT_SCR + wave * 128);
    if (h == 0) wsf[r] = 1.0f / lsum;
    LDS_WAIT(); asm volatile("" ::: "memory");
#pragma unroll
    for (int rr = 0; rr < 16; ++rr) {
        const int ql = crow(rr, h); const float inv = wsf[ql];
        const size_t m = rowbase + qs + ql;
        const bf16* gp = F.ZA() + m * NATC + 768 + 64 * hd + r;
        bf16* op = F.YMIX() + m * DMODEL + DHY + 64 * hd + r;
        op[0] = (bf16)f2bf(o0[rr] * inv * bf2f(gp[0]));
        op[32] = (bf16)f2bf(o1[rr] * inv * bf2f(gp[32]));
    }
}

__device__ __forceinline__ void p3_panel(Frame& F, int pm) {
    int tid = F.tid, lane = F.lane; const int wave = F.wave;
    asm volatile("" : "+v"(tid), "+v"(lane));
#ifndef P3_NO_A
    {
        const int ml = tid & 255, half = tid >> 8;
        const size_t m = (size_t)pm * 256 + ml;
        for (int oc = half * 32; oc < half * 32 + 32; ++oc) {
            const bf16* src = F.YT() + (size_t)(8 * oc) * MTOK + m;
            unsigned e[8];
#pragma unroll
            for (int i = 0; i < 8; ++i) e[i] = src[(size_t)i * MTOK];
            v4u w; w.x = e[0] | (e[1] << 16); w.y = e[2] | (e[3] << 16); w.z = e[4] | (e[5] << 16); w.w = e[6] | (e[7] << 16);
            *(v4u*)(F.YMIX() + m * DMODEL + 8 * oc) = w;
        }
    }
#endif
    __threadfence(); __syncthreads();
    {
        const bf16* w2 = F.W2T(); const bf16* ym = F.YMIX();
        asm volatile("" : "+s"(w2), "+s"(ym));
        pg8::Gemm g{ym, w2, MTOK, DMODEL, DMODEL}; pg8::PanelOrder S{pm, DMODEL / 256};
        pg8::EpiY E{F.YRAW(), DMODEL, F.SS()};
        pg8::gemm_phase<pg8::EpiY, pg8::PanelOrder, true, true>(F.lds, g, S, E);
    }
    __threadfence(); __syncthreads();
#ifndef P3_NO_C
    {
        f32x4 gq[4];
#pragma unroll
        for (int j = 0; j < 4; ++j) gq[j] = *((const f32x4*)F.post_g() + lane + 64 * j);
        for (int i = 0; i < 32; ++i) {
            const size_t row = (size_t)pm * 256 + wave * 32 + i;
            float ss = (lane < 16) ? F.SS()[row * 16 + lane] : 0.f;
            ss = wave_sum(ss);
            const float rstd = 1.0f / sqrtf(ss * (1.0f / DMODEL) + RMS_EPS);
            const v2u* yr = (const v2u*)(F.YRAW() + row * DMODEL) + lane;
            const f32x4* xr = (const f32x4*)(F.x() + row * DMODEL) + lane;
            f32x4* orow = (f32x4*)(F.out() + row * DMODEL) + lane;
#pragma unroll
            for (int j = 0; j < 4; ++j) { const v2u yw = yr[64 * j]; const f32x4 xv = xr[64 * j];
                f32x4 o; o.x = xv.x + bflo(yw.x) * rstd * gq[j].x; o.y = xv.y + bfhi(yw.x) * rstd * gq[j].y; o.z = xv.z + bflo(yw.y) * rstd * gq[j].z; o.w = xv.w + bfhi(yw.y) * rstd * gq[j].w;
                orow[64 * j] = o; }
        }
    }
#endif
    __syncthreads();
}

__global__ void __launch_bounds__(NTHREADS, 2) hybrid_fwd(Args args) {
    extern __shared__ __attribute__((aligned(16))) unsigned char lds_raw[];
    Frame F;
    F.lds = (LAS unsigned char*)lds_raw;
    F.tid = threadIdx.x; F.lane = F.tid & 63; F.wave = __builtin_amdgcn_readfirstlane(F.tid >> 6);
    F.G = gridDim.x; { const int bx = blockIdx.x; F.vcu = (F.G % 8 == 0) ? (bx % 8) * (F.G / 8) + bx / 8 : bx; }
    F.A = &args;
    const int lo = args.ph_lo, hi = args.ph_hi;
#define IN(k) (lo <= (k) && (k) < hi)
#define SEAM(k) do { if (IN(k) && IN((k) + 1)) { cg::this_grid().sync(); } } while (0)

#ifndef NO_P0
    if (IN(0)) { p0_prologue(F); }
#endif
    SEAM(0);
#ifndef NO_P1
    if (IN(1)) {
        { pg8::Gemm g{F.W1T(), F.XN(), NHYC, MTOK, DMODEL}; pg8::StaticOrder S; S.init(NHYC, MTOK, F.G, (int)blockIdx.x);
          pg8::EpiZT E{F.ZT(), MTOK};
          pg8::gemm_phase<pg8::EpiZT, pg8::StaticOrder, true, true>(F.lds, g, S, E); }
        { pg8::Gemm g{F.XN(), F.W1T() + (size_t)NHYC * DMODEL, MTOK, NATC, DMODEL}; pg8::StaticOrder S; S.init(MTOK, NATC, F.G, (int)blockIdx.x);
          pg8::EpiZA E{F.ZA(), NATC, QSCALE};
          pg8::gemm_phase<pg8::EpiZA, pg8::StaticOrder, true, true>(F.lds, g, S, E); }
    }
#endif
    SEAM(1);
    if (IN(2)) {
#ifndef NO_HY
        for (int c = F.vcu; c < DHY; c += F.G) hyena_unit(F, c);
#endif
        const int nau = BATCH * 2 * (SEQ / 64), per = (nau + F.G - 1) / F.G;
#ifndef NO_AT
        for (int i = 0; i < per; ++i) { const int u = F.vcu * per + i; if (u < nau) attn_unit(F, u); }
#endif
    }
    SEAM(2);
    if (IN(3)) {
#ifndef NO_P3
        for (int pm = F.vcu; pm < MTOK / 256; pm += F.G) p3_panel(F, pm);
#endif
    }
#undef IN
#undef SEAM
}

extern "C" void kernel_launch(void* const* d_in, const int* in_sizes, int n_in, void* d_out, int out_size, void* d_ws, size_t ws_size, hipStream_t stream) {
    static int grid = 0;
    if (grid == 0) {
        if (n_in != 17 || in_sizes[0] != MTOK * DMODEL || out_size != MTOK * DMODEL || ws_size < WS_END) {
            fprintf(stderr, "kernel_launch: unexpected shapes (n_in %d, in0 %d, out %d, ws %zu); nothing launched\n", n_in, n_in > 0 ? in_sizes[0] : -1, out_size, ws_size); grid = -1; return; }
        int dev = 0, cus = 0, per_cu = 0;
        if (hipGetDevice(&dev) != hipSuccess || hipDeviceGetAttribute(&cus, hipDeviceAttributeMultiprocessorCount, dev) != hipSuccess) { fprintf(stderr, "kernel_launch: device query failed\n"); grid = -1; return; }
        if (hipFuncSetAttribute((const void*)hybrid_fwd, hipFuncAttributeMaxDynamicSharedMemorySize, LDS_BYTES) != hipSuccess) { fprintf(stderr, "kernel_launch: hipFuncSetAttribute failed\n"); grid = -1; return; }
        if (hipOccupancyMaxActiveBlocksPerMultiprocessor(&per_cu, (const void*)hybrid_fwd, NTHREADS, LDS_BYTES) != hipSuccess || per_cu < 1) {
            fprintf(stderr, "kernel_launch: occupancy query reports %d workgroups per CU; nothing launched\n", per_cu); (void)hipGetLastError(); grid = -1; return; }
        grid = cus;
    }
    if (grid < 0) return;
    Args a{};
    for (int i = 0; i < 17; ++i) a.in[i] = (const float*)d_in[i];
    a.out = (float*)d_out; a.ws = (unsigned char*)d_ws;
#if MK_N_LAUNCHES == 1
    a.ph_lo = 0; a.ph_hi = 4;
    void* kargs[] = {&a};
    const hipError_t e = hipLaunchCooperativeKernel((const void*)hybrid_fwd, dim3(grid), dim3(NTHREADS), kargs, LDS_BYTES, stream);
    if (e != hipSuccess) fprintf(stderr, "kernel_launch: cooperative launch failed: %s (grid %d)\n", hipGetErrorString(e), grid);
#else
    for (int p = 0; p < 4; ++p) {
        a.ph_lo = p; a.ph_hi = p + 1;
        hipLaunchKernelGGL(hybrid_fwd, dim3(grid), dim3(NTHREADS), LDS_BYTES, stream, a);
        const hipError_t le = hipPeekAtLastError();
        if (le != hipSuccess) { fprintf(stderr, "kernel_launch: launch %d failed: %s\n", p, hipGetErrorName(le)); break; }
    }
#endif
}
```

```cpp
#include <hip/hip_runtime.h>
#include <hip/hip_cooperative_groups.h>
#include <cstdio>
#include <cstdint>
namespace cg = cooperative_groups;

#define RPT_P0 1
#define RPT_P1 1
#define RPT_HY 1
#define RPT_AT 1
#define RPT_P3 1
#ifndef MK_N_LAUNCHES
#define MK_N_LAUNCHES 1
#endif

namespace pg8 {
#define PG8_LAS __attribute__((address_space(3)))
typedef unsigned short bf16_t;
typedef short bf16x8 __attribute__((ext_vector_type(8)));
typedef float f32x4 __attribute__((ext_vector_type(4)));
typedef unsigned u32x4 __attribute__((ext_vector_type(4)));
constexpr int BM = 256, BK = 64, HALF = 128, HTB = HALF * BK * 2  , STAGE_BYTES = 8 * HTB, NXCD = 8, WGM = 8;

__host__ __device__ __forceinline__ int lds_byte(int r, int c) { const int st = (r >> 4) * 2 + (c >> 5), rr = r & 15, cc = c & 31, ob = rr * 64 + cc * 2; return st * 1024 + (ob ^ (((ob >> 9) & 1) << 5)); }
__host__ __device__ __forceinline__ void stage_rc(int b, int& R, int& C) { const int st = b / 1024, sb = b % 1024, swz = sb ^ (((sb >> 9) & 1) << 5); R = (st >> 1) * 16 + swz / 64; C = (st & 1) * 32 + (swz % 64) / 2; }
__host__ __device__ __forceinline__ int perm32(int rho) { const int n = rho >> 4, i = rho & 15; return 8 * (i >> 2) + 4 * n + (i & 3); }

struct Unit { int pm, pn; };
struct Gemm { const bf16_t* A; const bf16_t* Bt; int M, N, K; };

struct StaticOrder {
    int nM, nN, nwg, G, c;
    __host__ __device__ void init(int M, int N, int G_, int c_) { nM = M / BM; nN = N / BM; nwg = nM * nN; G = G_; c = c_; }
    __host__ __device__ bool next(int i, Unit& u) const {
        const long L = (long)i * G + c; if (L >= nwg) return false;
        int wgid = (int)L; { const int q = nwg / NXCD, r = nwg % NXCD, xcd = wgid % NXCD, off = wgid / NXCD; wgid = (xcd < r ? xcd * (q + 1) : r * (q + 1) + (xcd - r) * q) + off; }
        const int nig = WGM * nN, gid = wgid / nig, fm = gid * WGM, gsz = (nM - fm) < WGM ? (nM - fm) : WGM;
        u.pm = fm + ((wgid % nig) % gsz); u.pn = (wgid % nig) / gsz; return true;
    }
    __device__ __forceinline__ void a_ready(const Unit&) const {}
    __device__ __forceinline__ void done(const Unit&) const {}
};
struct PanelOrder {
    int pm, ntn;
    __device__ bool next(int i, Unit& u) const { if (i >= ntn) return false; u.pm = pm; u.pn = i; return true; }
    __device__ __forceinline__ void a_ready(const Unit&) const {}
    __device__ __forceinline__ void done(const Unit&) const {}
};

typedef float f32x2 __attribute__((ext_vector_type(2))); typedef __bf16 bf16x2_t __attribute__((ext_vector_type(2)));
__device__ __forceinline__ unsigned cvt_pk_bf16(float lo, float hi) { f32x2 v = {lo, hi}; bf16x2_t b = __builtin_convertvector(v, bf16x2_t); return __builtin_bit_cast(unsigned, b); }
__device__ __forceinline__ float silu_f(float v) { return v * __builtin_amdgcn_rcpf(1.0f + __expf(-v)); }
__device__ __forceinline__ f32x4 silu4(f32x4 v) { return (f32x4){silu_f(v[0]), silu_f(v[1]), silu_f(v[2]), silu_f(v[3])}; }

struct EpiZT {
    static constexpr bool PERM = true, AFTER_DRAIN = false;
    bf16_t* O; int ldc;
    __device__ __forceinline__ void operator()(const f32x4 (&acc)[2][2][4][2], const Unit& u, int wr, int wc, int fr, int fq) const {
        const int row0 = u.pm * BM + wr * 64 + fr, col0 = u.pn * BM + wc * 32 + 8 * fq; const bool act = (u.pm >= 6);
#pragma unroll
        for (int ai = 0; ai < 2; ++ai)
#pragma unroll
            for (int m = 0; m < 4; ++m) { bf16_t* rowp = O + (size_t)(row0 + ai * HALF + m * 16) * ldc + col0;
#pragma unroll
                for (int bj = 0; bj < 2; ++bj) { f32x4 v0 = acc[ai][bj][m][0], v1 = acc[ai][bj][m][1];
                    if (act) { v0 = silu4(v0); v1 = silu4(v1); }
                    u32x4 w; w.x = cvt_pk_bf16(v0[0], v0[1]); w.y = cvt_pk_bf16(v0[2], v0[3]); w.z = cvt_pk_bf16(v1[0], v1[1]); w.w = cvt_pk_bf16(v1[2], v1[3]);
                    *(u32x4*)(rowp + bj * HALF) = w; } }
    }
};
struct EpiZA {
    static constexpr bool PERM = true, AFTER_DRAIN = false;
    bf16_t* O; int ldc; float qscale;
    __device__ __forceinline__ void operator()(const f32x4 (&acc)[2][2][4][2], const Unit& u, int wr, int wc, int fr, int fq) const {
        const int row0 = u.pm * BM + wr * 64 + fr, col0 = u.pn * BM + wc * 32 + 8 * fq; const bool act = (u.pn >= 3); const float sc = (u.pn < 2) ? qscale : 1.0f;
#pragma unroll
        for (int ai = 0; ai < 2; ++ai)
#pragma unroll
            for (int m = 0; m < 4; ++m) { bf16_t* rowp = O + (size_t)(row0 + ai * HALF + m * 16) * ldc + col0;
#pragma unroll
                for (int bj = 0; bj < 2; ++bj) { f32x4 v0 = acc[ai][bj][m][0], v1 = acc[ai][bj][m][1];
                    if (act) { v0 = silu4(v0); v1 = silu4(v1); }
                    v0 = v0 * sc; v1 = v1 * sc;
                    u32x4 w; w.x = cvt_pk_bf16(v0[0], v0[1]); w.y = cvt_pk_bf16(v0[2], v0[3]); w.z = cvt_pk_bf16(v1[0], v1[1]); w.w = cvt_pk_bf16(v1[2], v1[3]);
                    *(u32x4*)(rowp + bj * HALF) = w; } }
    }
};
struct EpiY {
    static constexpr bool PERM = true, AFTER_DRAIN = false;
    bf16_t* O; int ldc; float* SS;
    __device__ __forceinline__ void operator()(const f32x4 (&acc)[2][2][4][2], const Unit& u, int wr, int wc, int fr_in, int fq) const {
        int fr = fr_in; asm volatile("" : "+v"(fr));
        const int row0 = u.pm * BM + wr * 64 + fr, col0 = u.pn * BM + wc * 32 + 8 * fq;
#pragma unroll
        for (int ai = 0; ai < 2; ++ai)
#pragma unroll
            for (int m = 0; m < 4; ++m) { const int row = row0 + ai * HALF + m * 16; bf16_t* rowp = O + (size_t)row * ldc + col0; float s = 0.f;
#pragma unroll
                for (int bj = 0; bj < 2; ++bj) { const f32x4 v0 = acc[ai][bj][m][0], v1 = acc[ai][bj][m][1];
                    s += (v0[0] * v0[0] + v0[1] * v0[1]) + (v0[2] * v0[2] + v0[3] * v0[3]) + (v1[0] * v1[0] + v1[1] * v1[1]) + (v1[2] * v1[2] + v1[3] * v1[3]);
                    u32x4 w; w.x = cvt_pk_bf16(v0[0], v0[1]); w.y = cvt_pk_bf16(v0[2], v0[3]); w.z = cvt_pk_bf16(v1[0], v1[1]); w.w = cvt_pk_bf16(v1[2], v1[3]);
                    *(u32x4*)(rowp + bj * HALF) = w; }
                s += __shfl_xor(s, 16); s += __shfl_xor(s, 32);
                if (fq == 0) SS[(size_t)row * 16 + u.pn * 4 + wc] = s;
                asm volatile("" ::: "memory"); }
    }
};

template <class Epi, class Sched, bool ALIGN_EPI = false, bool SP2 = false>
__device__ __forceinline__ void gemm_phase(PG8_LAS unsigned char* lds, const Gemm g, const Sched& S, const Epi& E) {
    int tid_l = threadIdx.x; asm volatile("" : "+v"(tid_l));
    const int tid = tid_l, wid = __builtin_amdgcn_readfirstlane(tid >> 6), lane = tid & 63, wr = wid >> 2, wc = wid & 3, fr = lane & 15, fq = lane >> 4;
    const int K = g.K, nt = K / BK;
    unsigned voffA[2], voffB[2];
#pragma unroll
    for (int i = 0; i < 2; ++i) { int R, C; stage_rc(tid * 16 + i * 8192, R, C); const int Rb = Epi::PERM ? ((R & ~31) + perm32(R & 31)) : R;
        voffA[i] = (unsigned)(R * K + C) * 2u; voffB[i] = (unsigned)(Rb * K + C) * 2u; }
    const size_t kstep = (size_t)(BK * 2);
    const size_t hstep = (size_t)HALF * K * 2;
    const size_t tstep = 2 * hstep;
    const unsigned ldsw = (unsigned)wid * 1024u;
    const int aoff = lds_byte(wr * 64 + fr, fq * 8), boff = lds_byte(wc * 32 + fr, fq * 8);
#define PG8_SA(b, h) (((b) * 2 + (h)) * HTB)
#define PG8_SB(b, h) ((4 + (b) * 2 + (h)) * HTB)
#define PG8_STAGE(bufoff, gbase, voff) do { _Pragma("unroll") for (int _i = 0; _i < 2; ++_i) \
        __builtin_amdgcn_global_load_lds((const unsigned*)((const char*)(gbase) + (voff)[_i]), (PG8_LAS unsigned*)(lds + (bufoff) + ldsw + _i * 8192), 16, 0, 0); } while (0)
#define PG8_LDA(dst, b, h) do { _Pragma("unroll") for (int m = 0; m < 4; ++m) _Pragma("unroll") for (int k = 0; k < 2; ++k) dst[m][k] = *(const PG8_LAS bf16x8*)(lds + PG8_SA(b, h) + aoff + m * 2048 + k * 1024); } while (0)
#define PG8_LDB(dst, b, h) do { _Pragma("unroll") for (int n = 0; n < 2; ++n) _Pragma("unroll") for (int k = 0; k < 2; ++k) dst[n][k] = *(const PG8_LAS bf16x8*)(lds + PG8_SB(b, h) + boff + n * 2048 + k * 1024); } while (0)
#define PG8_MMA(ai, bj, At, Bt) do { __builtin_amdgcn_s_setprio(1); _Pragma("unroll") for (int m = 0; m < 4; ++m) _Pragma("unroll") for (int n = 0; n < 2; ++n) _Pragma("unroll") for (int k = 0; k < 2; ++k) \
        acc[ai][bj][m][n] = __builtin_amdgcn_mfma_f32_16x16x32_bf16(Bt[n][k], At[m][k], acc[ai][bj][m][n], 0, 0, 0); __builtin_amdgcn_s_setprio(0); } while (0)
#define PG8_WAIT_V(n) asm volatile("s_waitcnt vmcnt(" #n ")" ::: "memory")
#define PG8_WAIT_L(n) asm volatile("s_waitcnt lgkmcnt(" #n ")" ::: "memory")
#define PG8_BAR __builtin_amdgcn_s_barrier()
#define PG8_SCHED __builtin_amdgcn_sched_barrier(0)
    Unit cur, nxt; int ui = 0;
    if (!S.next(0, cur)) return;
    f32x4 acc[2][2][4][2];
#pragma unroll
    for (int a = 0; a < 2; ++a)
#pragma unroll
        for (int b = 0; b < 2; ++b)
#pragma unroll
            for (int m = 0; m < 4; ++m)
#pragma unroll
                for (int n = 0; n < 2; ++n) acc[a][b][m][n] = (f32x4){0.f, 0.f, 0.f, 0.f};
    bf16x8 At[4][2], B0[2][2], B1[2][2];
    const char* cA = (const char*)g.A + (size_t)cur.pm * tstep; const char* cB = (const char*)g.Bt + (size_t)cur.pn * tstep;
    S.a_ready(cur);
    if constexpr (SP2) {
        PG8_STAGE(PG8_SB(0, 0), cB, voffB); PG8_STAGE(PG8_SB(0, 1), cB + hstep, voffB); PG8_STAGE(PG8_SA(0, 0), cA, voffA); PG8_STAGE(PG8_SA(0, 1), cA + hstep, voffA);
        if (wr == 1) PG8_BAR;
        PG8_WAIT_V(2); PG8_BAR;
        PG8_STAGE(PG8_SB(1, 0), cB + kstep, voffB); PG8_STAGE(PG8_SA(1, 0), cA + kstep, voffA); PG8_STAGE(PG8_SB(1, 1), cB + hstep + kstep, voffB);
        PG8_WAIT_V(6); PG8_BAR;
    } else {
        PG8_STAGE(PG8_SB(0, 0), cB, voffB); PG8_STAGE(PG8_SA(0, 0), cA, voffA); PG8_STAGE(PG8_SB(0, 1), cB + hstep, voffB); PG8_STAGE(PG8_SA(0, 1), cA + hstep, voffA);
        if (wr == 1) PG8_BAR;
        PG8_WAIT_V(4); PG8_BAR;
        PG8_STAGE(PG8_SB(1, 0), cB + kstep, voffB); PG8_STAGE(PG8_SA(1, 0), cA + kstep, voffA); PG8_STAGE(PG8_SB(1, 1), cB + hstep + kstep, voffB);
        PG8_WAIT_V(6); PG8_BAR;
    }
    for (;;) {
        const bool has_next = S.next(ui + 1, nxt);
        const char* nA = has_next ? (const char*)g.A + (size_t)nxt.pm * tstep : cA; const char* nB = has_next ? (const char*)g.Bt + (size_t)nxt.pn * tstep : cB;
        for (int t = 0; t < nt; t += 2) {
            const bool last = (t == nt - 2);
            const char* a1 = cA + (size_t)(t + 1) * kstep;
            const char* a2 = last ? nA : cA + (size_t)(t + 2) * kstep; const char* b2 = last ? nB : cB + (size_t)(t + 2) * kstep;
            const char* a3 = a2 + kstep; const char* b3 = b2 + kstep;
            if (last && has_next) S.a_ready(nxt);
            if constexpr (SP2) {
            PG8_LDB(B0, 0, 0); PG8_LDB(B1, 0, 1); PG8_SCHED; PG8_LDA(At, 0, 0); PG8_STAGE(PG8_SA(1, 1), a1 + hstep, voffA);
            PG8_WAIT_V(8); PG8_WAIT_L(0); PG8_BAR; PG8_MMA(0, 0, At, B0); PG8_MMA(0, 1, At, B1); PG8_BAR; PG8_SCHED;
            PG8_LDA(At, 0, 1); PG8_STAGE(PG8_SB(0, 0), b2, voffB); PG8_STAGE(PG8_SB(0, 1), b2 + hstep, voffB); PG8_STAGE(PG8_SA(0, 0), a2, voffA);
            PG8_WAIT_V(8); PG8_WAIT_L(0); PG8_BAR; PG8_MMA(1, 0, At, B0); PG8_MMA(1, 1, At, B1); PG8_BAR; PG8_SCHED;
            PG8_LDB(B0, 1, 0); PG8_LDB(B1, 1, 1); PG8_SCHED; PG8_LDA(At, 1, 0); PG8_STAGE(PG8_SA(0, 1), a2 + hstep, voffA);
            PG8_WAIT_V(8); PG8_WAIT_L(0); PG8_BAR; PG8_MMA(0, 0, At, B0); PG8_MMA(0, 1, At, B1); PG8_BAR; PG8_SCHED;
            PG8_LDA(At, 1, 1); PG8_STAGE(PG8_SB(1, 0), b3, voffB); PG8_STAGE(PG8_SB(1, 1), b3 + hstep, voffB); PG8_STAGE(PG8_SA(1, 0), a3, voffA);
            PG8_WAIT_V(8); PG8_WAIT_L(0); PG8_BAR; PG8_MMA(1, 0, At, B0); PG8_MMA(1, 1, At, B1); PG8_BAR; PG8_SCHED;
            } else {
            PG8_LDB(B0, 0, 0); PG8_SCHED; PG8_LDA(At, 0, 0); PG8_STAGE(PG8_SA(1, 1), a1 + hstep, voffA);
            PG8_WAIT_L(8); PG8_BAR; PG8_WAIT_L(0); PG8_MMA(0, 0, At, B0); PG8_BAR; PG8_SCHED;
            PG8_LDB(B1, 0, 1); PG8_STAGE(PG8_SB(0, 0), b2, voffB);
            PG8_BAR; PG8_WAIT_L(0); PG8_MMA(0, 1, At, B1); PG8_BAR;
            PG8_LDA(At, 0, 1); PG8_STAGE(PG8_SA(0, 0), a2, voffA);
            PG8_BAR; PG8_WAIT_L(0); PG8_MMA(1, 0, At, B0); PG8_BAR; PG8_SCHED;
            PG8_STAGE(PG8_SB(0, 1), b2 + hstep, voffB);
            PG8_WAIT_V(6); PG8_BAR; PG8_MMA(1, 1, At, B1); PG8_BAR;
            PG8_LDB(B0, 1, 0); PG8_SCHED; PG8_LDA(At, 1, 0); PG8_STAGE(PG8_SA(0, 1), a2 + hstep, voffA);
            PG8_WAIT_L(8); PG8_BAR; PG8_WAIT_L(0); PG8_MMA(0, 0, At, B0); PG8_BAR; PG8_SCHED;
            PG8_LDB(B1, 1, 1); PG8_STAGE(PG8_SB(1, 0), b3, voffB);
            PG8_BAR; PG8_WAIT_L(0); PG8_MMA(0, 1, At, B1); PG8_BAR;
            PG8_LDA(At, 1, 1); PG8_STAGE(PG8_SA(1, 0), a3, voffA);
            PG8_BAR; PG8_WAIT_L(0); PG8_MMA(1, 0, At, B0); PG8_BAR; PG8_SCHED;
            PG8_STAGE(PG8_SB(1, 1), b3 + hstep, voffB);
            PG8_WAIT_V(6); PG8_BAR; PG8_MMA(1, 1, At, B1); PG8_BAR;
            }
        }
        if constexpr (ALIGN_EPI) { if (wr == 0) PG8_BAR; }
        if constexpr (!Epi::AFTER_DRAIN) { E(acc, cur, wr, wc, fr, fq); S.done(cur); }
        if (!has_next) break;
#pragma unroll
        for (int a = 0; a < 2; ++a)
#pragma unroll
            for (int b = 0; b < 2; ++b)
#pragma unroll
                for (int m = 0; m < 4; ++m)
#pragma unroll
                    for (int n = 0; n < 2; ++n) acc[a][b][m][n] = (f32x4){0.f, 0.f, 0.f, 0.f};
        cur = nxt; cA = nA; cB = nB; ++ui;
        if constexpr (ALIGN_EPI) { if (wr == 1) PG8_BAR; }
    }
    PG8_WAIT_V(0);
    if constexpr (!ALIGN_EPI) { if (wr == 0) PG8_BAR; }
    PG8_BAR;
    if constexpr (Epi::AFTER_DRAIN) { E.fused(acc, cur, wr, wc, fr, fq, lds, wid, lane); S.done(cur); }
#undef PG8_SA
#undef PG8_SB
#undef PG8_STAGE
#undef PG8_LDA
#undef PG8_LDB
#undef PG8_MMA
#undef PG8_WAIT_V
#undef PG8_WAIT_L
#undef PG8_BAR
#undef PG8_SCHED
}
}

constexpr int NWAVES = 8, NTHREADS = 512;
constexpr int BATCH = 32, SEQ = 2048, DMODEL = 1024, MTOK = BATCH * SEQ;
constexpr int DHY = 512, NHYC = 2048  , NATC = 1280  , NIN = 3328;
constexpr int NHEADS = 8, HD = 64, WIN = 128;
constexpr float RMS_EPS = 1e-6f, LOG2E = 1.4426950408889634f;
constexpr float QSCALE = 0.125f * LOG2E;

constexpr size_t MiB = 1u << 20;
constexpr size_t WS_W1T = 2 * MiB;
constexpr size_t WS_W2T = 10 * MiB;
constexpr size_t WS_FRAW = 12 * MiB;
constexpr size_t WS_SS = 20 * MiB;
constexpr size_t WS_XN = 32 * MiB;
constexpr size_t WS_ZT = 160 * MiB;
constexpr size_t WS_ZA = 416 * MiB;
constexpr size_t WS_YT = 576 * MiB;
constexpr size_t WS_YMIX = 640 * MiB;
constexpr size_t WS_YRAW = 768 * MiB;
constexpr size_t WS_END = 896 * MiB;

constexpr int LDS_BYTES = 147456;

#define LAS __attribute__((address_space(3)))
typedef unsigned short bf16;
typedef unsigned v4u __attribute__((ext_vector_type(4)));
typedef unsigned v2u __attribute__((ext_vector_type(2)));
typedef float f32x4 __attribute__((ext_vector_type(4)));
typedef float f32x16 __attribute__((ext_vector_type(16)));
typedef short bf16x8 __attribute__((ext_vector_type(8)));
typedef short s16x4 __attribute__((ext_vector_type(4)));
#define LDS_WAIT() asm volatile("s_waitcnt lgkmcnt(0)" ::: "memory")
#define VM_WAIT() asm volatile("s_waitcnt vmcnt(0)" ::: "memory")
__device__ __forceinline__ unsigned f2bf(float f) { unsigned u = __builtin_bit_cast(unsigned, f); return (u + 0x7fffu + ((u >> 16) & 1u)) >> 16; }
__device__ __forceinline__ unsigned pk2(float lo, float hi) { return pg8::cvt_pk_bf16(lo, hi); }
__device__ __forceinline__ float bf2f(unsigned u16) { return __uint_as_float(u16 << 16); }
__device__ __forceinline__ float bflo(unsigned w) { return __uint_as_float(w << 16); }
__device__ __forceinline__ float bfhi(unsigned w) { return __uint_as_float(w & 0xffff0000u); }
__device__ __forceinline__ int crow(int r, int hi) { return (r & 3) + 8 * (r >> 2) + 4 * hi; }
__device__ __forceinline__ float wave_sum(float v) {
#pragma unroll
    for (int o = 1; o < 64; o <<= 1) v += __shfl_xor(v, o);
    return v;
}

struct Args { const float* in[17]; float* out; unsigned char* ws; int ph_lo, ph_hi; };
struct Frame {
    LAS unsigned char* lds;
    int tid, lane, wave, vcu, G;
    const Args* A;
#define FRAME_IN(name, k) __device__ __forceinline__ const float* name() const { return A->in[k]; }
    FRAME_IN(x, 0) FRAME_IN(pre_g, 1) FRAME_IN(w_in, 2) FRAME_IN(w_short, 3) FRAME_IN(b_short, 4) FRAME_IN(w_f1, 5) FRAME_IN(b_f1, 6) FRAME_IN(w_f2, 7) FRAME_IN(b_f2, 8)
    FRAME_IN(w_f3, 9) FRAME_IN(b_f3, 10) FRAME_IN(w_f4, 11) FRAME_IN(sin_freq, 12) FRAME_IN(hyena_d, 13) FRAME_IN(attn_sink, 14) FRAME_IN(w_out, 15) FRAME_IN(post_g, 16)
#undef FRAME_IN
    __device__ __forceinline__ float* out() const { return A->out; }
#define FRAME_WS(type, name, off) __device__ __forceinline__ type* name() const { return (type*)(A->ws + (off)); }
    FRAME_WS(bf16, W1T, WS_W1T) FRAME_WS(bf16, W2T, WS_W2T) FRAME_WS(float, FRAW, WS_FRAW) FRAME_WS(float, SS, WS_SS) FRAME_WS(bf16, XN, WS_XN)
    FRAME_WS(bf16, ZT, WS_ZT) FRAME_WS(bf16, ZA, WS_ZA) FRAME_WS(bf16, YT, WS_YT) FRAME_WS(bf16, YMIX, WS_YMIX) FRAME_WS(bf16, YRAW, WS_YRAW)
#undef FRAME_WS
};

__device__ __forceinline__ float sin_rev(float x) { const float rv = x * 0.15915494309189535f; return __builtin_amdgcn_sinf(rv - floorf(rv)); }
__device__ __forceinline__ float cos_rev(float x) { const float rv = x * 0.15915494309189535f; return __builtin_amdgcn_cosf(rv - floorf(rv)); }
__device__ __forceinline__ void p0_transpose_item(const float* W, int K, int N, bf16* WT, const float* gk, LAS float* scr, int item, int lane) {
    const int nblk = N / 32, kb = item / nblk, nb = item % nblk, k0 = 64 * kb, n0 = 32 * nb;
#pragma unroll 8
    for (int i = 0; i < 32; ++i) { const int kk = 2 * i + (lane >> 5); scr[kk * 33 + (lane & 31)] = W[(size_t)(k0 + kk) * N + n0 + (lane & 31)]; }
    LDS_WAIT(); asm volatile("" ::: "memory");
    const int c = lane & 7;
    float g8[8];
#pragma unroll
    for (int i = 0; i < 8; ++i) g8[i] = gk ? gk[k0 + 8 * c + i] : 1.0f;
#pragma unroll
    for (int j = 0; j < 4; ++j) { const int n = (lane >> 3) + 8 * j; const LAS float* s = scr + (8 * c) * 33 + n;
        v4u o; o.x = pk2(s[0 * 33] * g8[0], s[1 * 33] * g8[1]); o.y = pk2(s[2 * 33] * g8[2], s[3 * 33] * g8[3]); o.z = pk2(s[4 * 33] * g8[4], s[5 * 33] * g8[5]); o.w = pk2(s[6 * 33] * g8[6], s[7 * 33] * g8[7]);
        *(v4u*)(WT + (size_t)(n0 + n) * K + k0 + 8 * c) = o; }
    LDS_WAIT(); asm volatile("" ::: "memory");
}
__device__ __forceinline__ void rms_rows4_to_bf16(const float* x0, bf16* o0, int lane) {
    f32x4 v[4][4]; float s[4];
#pragma unroll
    for (int q = 0; q < 4; ++q) { const f32x4* xr = (const f32x4*)(x0 + (size_t)q * DMODEL) + lane;
#pragma unroll
        for (int j = 0; j < 4; ++j) v[q][j] = xr[64 * j]; }
#pragma unroll
    for (int q = 0; q < 4; ++q) { float a = 0.f;
#pragma unroll
        for (int j = 0; j < 4; ++j) a += (v[q][j].x * v[q][j].x + v[q][j].y * v[q][j].y) + (v[q][j].z * v[q][j].z + v[q][j].w * v[q][j].w);
        s[q] = a; }
#pragma unroll
    for (int o = 1; o < 64; o <<= 1) {
#pragma unroll
        for (int q = 0; q < 4; ++q) s[q] += __shfl_xor(s[q], o); }
#pragma unroll
    for (int q = 0; q < 4; ++q) { const float rstd = 1.0f / sqrtf(s[q] * (1.0f / DMODEL) + RMS_EPS);
        v2u* o8 = (v2u*)(o0 + (size_t)q * DMODEL) + lane;
#pragma unroll
        for (int j = 0; j < 4; ++j) { v2u w; w.x = pk2(v[q][j].x * rstd, v[q][j].y * rstd); w.y = pk2(v[q][j].z * rstd, v[q][j].w * rstd); o8[64 * j] = w; } }
}
__device__ __forceinline__ void p0_filter_item(Frame& F, int item) {
    const int lane = F.lane, wave = F.wave, t = 8 * item + wave;
    LAS float* zs = (LAS float*)(F.lds + wave * 16384);
    LAS float* fo = (LAS float*)(F.lds + wave * 16384 + 4096);
    const float tn = (float)t / 2047.0f;
    const float w = (6.2831855f * (float)t) / 2048.0f;
    {
        float z = 0.f;
        if (lane == 0) z = tn;
        else if (lane <= 32) {
            const int i = (lane - 1) & 15;
            const float band = (float)(1e-4 + (double)i * ((15.0 - 1e-4) / 15.0));
            const float ang = w * band;
            z = (lane <= 16) ? cos_rev(ang) : -sin_rev(ang);
        }
        zs[lane] = z;
    }
    __syncthreads();
    {
        float a = 0.f;
#pragma unroll 3
        for (int k = 0; k < 33; ++k) a += zs[k] * F.w_f1()[k * 64 + lane];
        a += F.b_f1()[lane];
        zs[64 + lane] = sin_rev(F.sin_freq()[lane] * a);
    }
    __syncthreads();
    {
        float a = 0.f;
#pragma unroll 4
        for (int k = 0; k < 64; ++k) a += zs[64 + k] * F.w_f2()[k * 64 + lane];
        a += F.b_f2()[lane];
        zs[128 + lane] = sin_rev(F.sin_freq()[64 + lane] * a);
    }
    __syncthreads();
    {
        float a = 0.f;
#pragma unroll 4
        for (int k = 0; k < 64; ++k) a += zs[128 + k] * F.w_f3()[k * 64 + lane];
        a += F.b_f3()[lane];
        zs[192 + lane] = sin_rev(F.sin_freq()[128 + lane] * a);
    }
    __syncthreads();
    {
        float a[16];
#pragma unroll
        for (int j = 0; j < 16; ++j) a[j] = 0.f;
#pragma unroll 2
        for (int k = 0; k < 64; ++k) { const float hk = zs[192 + k]; const float* wr = F.w_f4() + (size_t)k * 1024 + lane;
#pragma unroll
            for (int j = 0; j < 16; ++j) a[j] += hk * wr[64 * j]; }
        const double min_decay = -4.605170185988091 / 1.5, max_decay = -4.605170185988091 / 0.3;
#pragma unroll
        for (int j = 0; j < 16; ++j) { const int col = lane + 64 * j, c = col & 511;
            double dl = min_decay + (double)c * ((max_decay - min_decay) / 511.0); if (c == 511) dl = max_decay;
            const float delta = (float)(dl < 0 ? -dl : dl);
            fo[col] = a[j] * expf(-(tn * delta)); }
    }
    __syncthreads();
    {
        const int tid = F.tid;
#pragma unroll
        for (int cc = 0; cc < 2; ++cc) { const int col = tid + 512 * cc; float v[8];
#pragma unroll
            for (int p = 0; p < 8; ++p) v[p] = *(const LAS float*)(F.lds + p * 16384 + 4096 + col * 4);
            f32x4* dst = (f32x4*)(F.FRAW() + (size_t)col * SEQ + 8 * item);
            dst[0] = (f32x4){v[0], v[1], v[2], v[3]}; dst[1] = (f32x4){v[4], v[5], v[6], v[7]}; }
    }
    __syncthreads();
}
__device__ __forceinline__ void p0_prologue(Frame& F) {
    LAS float* scr = (LAS float*)(F.lds + F.wave * 16384);
    const int gw = F.vcu * NWAVES + F.wave, NGW = F.G * NWAVES;
    constexpr int I1 = (DMODEL / 64) * (NIN / 32), I2 = (DMODEL / 64) * (DMODEL / 32);
    for (int it = gw; it < I1 + I2; it += NGW) {
        if (it < I1) p0_transpose_item(F.w_in(), DMODEL, NIN, F.W1T(), F.pre_g(), scr, it, F.lane);
        else p0_transpose_item(F.w_out(), DMODEL, DMODEL, F.W2T(), nullptr, scr, it - I1, F.lane);
    }
    for (int m4 = gw; m4 < MTOK / 4; m4 += NGW) rms_rows4_to_bf16(F.x() + (size_t)m4 * 4 * DMODEL, F.XN() + (size_t)m4 * 4 * DMODEL, F.lane);
    __syncthreads();
    for (int it = F.vcu; it < SEQ / 8; it += F.G) p0_filter_item(F, it);
}

constexpr int HY_CS = 8256;
constexpr int HY_TBL = 0, HY_VB = 8 * HY_CS;
constexpr int HY_VSTR = 2064;
constexpr int HY_SCW = 32 * 132 * 4;
static_assert(HY_VB + 32 * HY_VSTR <= LDS_BYTES && 8 * HY_SCW <= LDS_BYTES, "hyena LDS map");

__device__ __forceinline__ void conv8(float (&o)[8], const v4u c, float left, float right, float w0, float w1, float w2, float bias) {
    float e[10]; e[0] = left; e[9] = right;
    e[1] = bflo(c.x); e[2] = bfhi(c.x); e[3] = bflo(c.y); e[4] = bfhi(c.y); e[5] = bflo(c.z); e[6] = bfhi(c.z); e[7] = bflo(c.w); e[8] = bfhi(c.w);
#pragma unroll
    for (int j = 0; j < 8; ++j) o[j] = ((e[j] * w0 + e[j + 1] * w1) + e[j + 2] * w2) + bias;
}

__device__ __forceinline__ void hyena_unit(Frame& F, int c) {
    int tid = F.tid; asm volatile("" : "+v"(tid));
    const int lane = tid & 63, wave = F.wave, r = lane & 31, h = lane >> 5;
    LAS unsigned char* lds = F.lds;
    __syncthreads();
    {
        const float* ff = F.FRAW() + (size_t)c * SEQ; const float* fb = F.FRAW() + (size_t)(DHY + c) * SEQ;
        float rv[8]; float ssq = 0.f;
#pragma unroll
        for (int j = 0; j < 8; ++j) { const int n = tid + 512 * j; float v = 0.f;
            if (n <= 2047) v = ff[2047 - n]; else if (n <= 4094) v = fb[n - 2047];
            rv[j] = v; ssq += v * v; }
        ssq = wave_sum(ssq);
        LAS float* red = (LAS float*)(lds + HY_VB);
        if (lane == 0) red[wave] = ssq;
        __syncthreads();
        float tot = 0.f;
#pragma unroll
        for (int i = 0; i < 8; ++i) tot += red[i];
        const float scale = 1.0f / sqrtf(tot + 1e-12f);
#pragma unroll
        for (int j = 0; j < 8; ++j) { const int n = tid + 512 * j; const unsigned short bfv = (unsigned short)f2bf(rv[j] * scale);
#pragma unroll
            for (int q = 0; q < 8; ++q) { const int m = n - q; if (m >= 0) *(LAS unsigned short*)(lds + HY_TBL + q * HY_CS + 2 * m) = bfv; } }
    }
    const float wx0_0 = F.w_short()[c], wx0_1 = F.w_short()[1536 + c], wx0_2 = F.w_short()[3072 + c], bx0 = F.b_short()[c];
    const float wx1_0 = F.w_short()[DHY + c], wx1_1 = F.w_short()[1536 + DHY + c], wx1_2 = F.w_short()[3072 + DHY + c], bx1 = F.b_short()[DHY + c];
    const float wv_0 = F.w_short()[2 * DHY + c], wv_1 = F.w_short()[1536 + 2 * DHY + c], wv_2 = F.w_short()[3072 + 2 * DHY + c], bv = F.b_short()[2 * DHY + c];
    const float dskip = F.hyena_d()[c];
    const bf16* x0row = F.ZT() + (size_t)c * MTOK; const bf16* x1row = F.ZT() + (size_t)(DHY + c) * MTOK;
    const bf16* vrow = F.ZT() + (size_t)(2 * DHY + c) * MTOK; const bf16* grow = F.ZT() + (size_t)(3 * DHY + c) * MTOK;

    f32x16 acc[8];
#pragma unroll
    for (int i = 0; i < 8; ++i) acc[i] = f32x16{};
    bf16x8 fr[16];
    const int q = 7 - (r & 7);
    const int abase = HY_TBL + q * HY_CS + 4080 - 16 * (r >> 3) + 16 * h;
    const int bbase = HY_VB + r * HY_VSTR + 16 * h;
#define HY_LDA(a) (*(const LAS bf16x8*)(lds + abase - 32 * (a)))
#pragma unroll 1
    for (int ch = 0; ch < 2; ++ch) {
        __syncthreads();
#pragma unroll 1
        for (int itg = 0; itg < 2; ++itg) {
            v4u c1[4], cv[4]; unsigned hl1[4], hr1[4], hlv[4], hrv[4];
#pragma unroll
            for (int u = 0; u < 4; ++u) {
                const int idx = (itg * 4 + u) * 512 + tid, b = idx >> 7, sg = idx & 127, s = ch * 1024 + 8 * sg;
                const bf16* p1 = x1row + b * SEQ + s; const bf16* pv = vrow + b * SEQ + s;
                c1[u] = *(const v4u*)p1; cv[u] = *(const v4u*)pv;
                hl1[u] = p1[(s > 0) ? -1 : 0]; hr1[u] = p1[(s + 8 < SEQ) ? 8 : 7]; hlv[u] = pv[(s > 0) ? -1 : 0]; hrv[u] = pv[(s + 8 < SEQ) ? 8 : 7];
            }
#pragma unroll
            for (int u = 0; u < 4; ++u) {
                const int idx = (itg * 4 + u) * 512 + tid, b = idx >> 7, sg = idx & 127, s = ch * 1024 + 8 * sg;
                const float l1 = (s > 0) ? bf2f(hl1[u]) : 0.f, r1 = (s + 8 < SEQ) ? bf2f(hr1[u]) : 0.f;
                const float lv = (s > 0) ? bf2f(hlv[u]) : 0.f, rv_ = (s + 8 < SEQ) ? bf2f(hrv[u]) : 0.f;
                float o1[8], ov[8];
                conv8(o1, c1[u], l1, r1, wx1_0, wx1_1, wx1_2, bx1);
                conv8(ov, cv[u], lv, rv_, wv_0, wv_1, wv_2, bv);
                v4u w; w.x = pk2(ov[0] * o1[0], ov[1] * o1[1]); w.y = pk2(ov[2] * o1[2], ov[3] * o1[3]); w.z = pk2(ov[4] * o1[4], ov[5] * o1[5]); w.w = pk2(ov[6] * o1[6], ov[7] * o1[7]);
                *(LAS v4u*)(lds + HY_VB + b * HY_VSTR + sg * 16) = w;
            }
        }
        __syncthreads();
        {
#pragma unroll
            for (int s_ = 0; s_ < 15; ++s_) fr[s_] = HY_LDA(16 * wave - 64 * ch + s_);
            fr[15] = HY_LDA(16 * wave - 64 * ch - 1);
        }
#pragma unroll 1
        for (int body = 0; body < 4; ++body) {
            const int kl0 = body * 16, kg0 = ch * 64 + kl0;
#pragma unroll
            for (int kk = 0; kk < 16; ++kk) {
                const bf16x8 bfrag = *(const LAS bf16x8*)(lds + bbase + 32 * (kl0 + kk));
#pragma unroll
                for (int i = 0; i < 8; ++i) acc[i] = __builtin_amdgcn_mfma_f32_32x32x16_bf16(fr[(2 * i - kk) & 15], bfrag, acc[i], 0, 0, 0);
                fr[(14 - kk) & 15] = HY_LDA(16 * wave - 2 - (kg0 + kk));
            }
        }
    }
#undef HY_LDA
    __syncthreads();
    LAS float* sc = (LAS float*)(lds + wave * HY_SCW);
#pragma unroll
    for (int hh = 0; hh < 2; ++hh) {
#pragma unroll
        for (int ii = 0; ii < 4; ++ii)
#pragma unroll
            for (int rr = 0; rr < 16; ++rr) sc[r * 132 + 32 * ii + crow(rr, h)] = acc[4 * hh + ii][rr];
        LDS_WAIT(); asm volatile("" ::: "memory");
#pragma unroll 1
        for (int itg = 0; itg < 4; ++itg) {
            v4u c0[2], c1[2], cv[2], cgt[2]; unsigned hl0[2], hr0[2], hl1[2], hr1[2], hlv[2], hrv[2];
#pragma unroll
            for (int u = 0; u < 2; ++u) {
                const int b = 4 * (itg * 2 + u) + (lane >> 4), tg = lane & 15, t = 256 * wave + 128 * hh + 8 * tg;
                const size_t off = (size_t)b * SEQ + t;
                const bf16* p0 = x0row + off; const bf16* p1 = x1row + off; const bf16* pv = vrow + off;
                c0[u] = *(const v4u*)p0; c1[u] = *(const v4u*)p1; cv[u] = *(const v4u*)pv; cgt[u] = *(const v4u*)(grow + off);
                const int lo_ = (t > 0) ? -1 : 0, hi_ = (t + 8 < SEQ) ? 8 : 7;
                hl0[u] = p0[lo_]; hr0[u] = p0[hi_]; hl1[u] = p1[lo_]; hr1[u] = p1[hi_]; hlv[u] = pv[lo_]; hrv[u] = pv[hi_];
            }
#pragma unroll
            for (int u = 0; u < 2; ++u) {
                const int b = 4 * (itg * 2 + u) + (lane >> 4), tg = lane & 15, t = 256 * wave + 128 * hh + 8 * tg;
                const size_t off = (size_t)b * SEQ + t;
                const f32x4 y0 = *(const LAS f32x4*)(sc + b * 132 + 8 * tg), y1 = *(const LAS f32x4*)(sc + b * 132 + 8 * tg + 4);
                const bool hasl = t > 0, hasr = (t + 8 < SEQ);
                const float l0 = hasl ? bf2f(hl0[u]) : 0.f, r0 = hasr ? bf2f(hr0[u]) : 0.f;
                const float l1 = hasl ? bf2f(hl1[u]) : 0.f, r1 = hasr ? bf2f(hr1[u]) : 0.f;
                const float lv = hasl ? bf2f(hlv[u]) : 0.f, rv_ = hasr ? bf2f(hrv[u]) : 0.f;
                float o0[8], o1[8], ov[8];
                conv8(o0, c0[u], l0, r0, wx0_0, wx0_1, wx0_2, bx0);
                conv8(o1, c1[u], l1, r1, wx1_0, wx1_1, wx1_2, bx1);
                conv8(ov, cv[u], lv, rv_, wv_0, wv_1, wv_2, bv);
                const float yv[8] = {y0[0], y0[1], y0[2], y0[3], y1[0], y1[1], y1[2], y1[3]};
                const v4u cg_ = cgt[u];
                const float gt[8] = {bflo(cg_.x), bfhi(cg_.x), bflo(cg_.y), bfhi(cg_.y), bflo(cg_.z), bfhi(cg_.z), bflo(cg_.w), bfhi(cg_.w)};
                float res[8];
#pragma unroll
                for (int j = 0; j < 8; ++j) { const float vv = ov[j] * o1[j]; res[j] = ((yv[j] + vv * dskip) * o0[j]) * gt[j]; }
                v4u w; w.x = pk2(res[0], res[1]); w.y = pk2(res[2], res[3]); w.z = pk2(res[4], res[5]); w.w = pk2(res[6], res[7]);
                *(v4u*)(F.YT() + (size_t)c * MTOK + off) = w;
            }
        }
        LDS_WAIT(); asm volatile("" ::: "memory");
    }
}

constexpr int AT_QB = 128, AT_KSTR = 144, AT_VSTR = 192, AT_ROWS = AT_QB + 2 * WIN;
constexpr int AT_KS = 0, AT_VS = AT_ROWS * AT_KSTR  , AT_SCR = AT_VS + AT_ROWS * AT_VSTR  ;
constexpr int AT_UNITS = BATCH * 2 * (SEQ / AT_QB);
static_assert(AT_SCR + 8 * 128 <= LDS_BYTES, "attention LDS map");

__device__ __forceinline__ s16x4 lds_tr(const LAS unsigned char* p) {
    typedef short v4i16_t __attribute__((ext_vector_type(4)));
    return __builtin_bit_cast(s16x4, __builtin_amdgcn_ds_read_tr16_b64_v4i16((LAS v4i16_t*)p));
}

__device__ __forceinline__ void attn_unit(Frame& F, int uidx) {
    int tid = F.tid; asm volatile("" : "+v"(tid));
    const int lane = tid & 63, wave = F.wave, r = lane & 31, h = lane >> 5;
    LAS unsigned char* lds = F.lds;
    const int qb = uidx & 15, kvh = (uidx >> 4) & 1, b = uidx >> 5;
    const int q0 = qb * AT_QB, kbase = q0 - WIN; const size_t rowbase = (size_t)b * SEQ;
    __syncthreads();
    {
        v4u kk[6], vv[6];
#pragma unroll
        for (int u = 0; u < 6; ++u) { const int p = tid + u * NTHREADS, row = p >> 3, pc = p & 7, key = kbase + row;
            kk[u] = (v4u){0u, 0u, 0u, 0u}; vv[u] = (v4u){0u, 0u, 0u, 0u};
            if (key >= 0 && key < SEQ) { const bf16* src = F.ZA() + (rowbase + key) * NATC + 512 + 64 * kvh + 8 * pc; kk[u] = *(const v4u*)src; vv[u] = *(const v4u*)(src + 128); } }
#pragma unroll
        for (int u = 0; u < 6; ++u) { const int p = tid + u * NTHREADS, row = p >> 3, pc = p & 7;
            *(LAS v4u*)(lds + AT_KS + row * AT_KSTR + pc * 16) = kk[u];
            *(LAS v4u*)(lds + AT_VS + row * AT_VSTR + pc * 16) = vv[u]; }
    }
    __syncthreads();
    const int g = wave >> 1, hd = 4 * kvh + g;
    const float slope2 = exp2f(-(float)(hd + 1)) * LOG2E, sink2 = F.attn_sink()[hd] * LOG2E;
    float crel[16];
#pragma unroll
    for (int rr = 0; rr < 16; ++rr) { const int cr = crow(rr, h); crel[rr] = (float)(cr - r - WIN); }
    LAS float* wsf = (LAS float*)(lds + AT_SCR + wave * 128);
#pragma unroll 1
    for (int sb = 0; sb < 2; ++sb) {
        const int sub = 2 * (wave & 1) + sb, qs = q0 + 32 * sub;
        bf16x8 qf[4];
        { const bf16* qp = F.ZA() + (rowbase + qs + r) * NATC + 64 * hd + 8 * h;
#pragma unroll
          for (int d = 0; d < 4; ++d) qf[d] = *(const bf16x8*)(qp + 16 * d); }
        const int jlo = (4 - (qs >> 5)) > 0 ? (4 - (qs >> 5)) : 0, jhi = (((SEQ - qs) >> 5) + 3) < 8 ? (((SEQ - qs) >> 5) + 3) : 8;
        const LAS unsigned char* kp = lds + AT_KS + (32 * sub + r) * AT_KSTR + 16 * h;
        const LAS unsigned char* vp = lds + AT_VS + (32 * sub + 4 * h + ((lane & 15) >> 2)) * AT_VSTR + (16 * ((lane >> 4) & 1) + 4 * (lane & 3)) * 2;
#define AT_SCORES(S, j) do { S = f32x16{}; \
            _Pragma("unroll") for (int d = 0; d < 4; ++d) { const bf16x8 kf = *(const LAS bf16x8*)(kp + (j) * 32 * AT_KSTR + d * 32); S = __builtin_amdgcn_mfma_f32_32x32x16_bf16(kf, qf[d], S, 0, 0, 0); } \
            const float jo_ = (float)(32 * (j)); \
            _Pragma("unroll") for (int rr = 0; rr < 16; ++rr) S[rr] = S[rr] - slope2 * __builtin_fabsf(crel[rr] + jo_); \
            if ((j) == 0) { _Pragma("unroll") for (int rr = 0; rr < 16; ++rr) S[rr] = (crel[rr] >= -(float)WIN) ? S[rr] : -1e30f; } \
            if ((j) == 8) { _Pragma("unroll") for (int rr = 0; rr < 16; ++rr) S[rr] = (crel[rr] <= -(float)WIN) ? S[rr] : -1e30f; } } while (0)
        float mx = sink2;
#pragma unroll 1
        for (int j = jlo; j <= jhi; ++j) { f32x16 S; AT_SCORES(S, j);
#pragma unroll
            for (int rr = 0; rr < 16; ++rr) mx = fmaxf(mx, S[rr]); }
        mx = fmaxf(mx, __shfl_xor(mx, 32));
        float lsum = 0.f; f32x16 o0 = f32x16{}, o1 = f32x16{};
#pragma unroll 1
        for (int j = jlo; j <= jhi; ++j) { f32x16 S; AT_SCORES(S, j);
#pragma unroll
            for (int rr = 0; rr < 16; ++rr) { const float pexp = __builtin_amdgcn_exp2f(S[rr] - mx); S[rr] = pexp; lsum += pexp; }
#pragma unroll
            for (int ks = 0; ks < 2; ++ks) {
                v4u pw; pw.x = pk2(S[8 * ks + 0], S[8 * ks + 1]); pw.y = pk2(S[8 * ks + 2], S[8 * ks + 3]); pw.z = pk2(S[8 * ks + 4], S[8 * ks + 5]); pw.w = pk2(S[8 * ks + 6], S[8 * ks + 7]);
                const bf16x8 pf = __builtin_bit_cast(bf16x8, pw);
                const LAS unsigned char* vb = vp + (j * 32 + 16 * ks) * AT_VSTR;
                { const s16x4 lo = lds_tr(vb), hi4 = lds_tr(vb + 8 * AT_VSTR);
                  const bf16x8 vf = (bf16x8){lo[0], lo[1], lo[2], lo[3], hi4[0], hi4[1], hi4[2], hi4[3]};
                  o0 = __builtin_amdgcn_mfma_f32_32x32x16_bf16(pf, vf, o0, 0, 0, 0); }
                { const s16x4 lo = lds_tr(vb + 64), hi4 = lds_tr(vb + 64 + 8 * AT_VSTR);
                  const bf16x8 vf = (bf16x8){lo[0], lo[1], lo[2], lo[3], hi4[0], hi4[1], hi4[2], hi4[3]};
                  o1 = __builtin_amdgcn_mfma_f32_32x32x16_bf16(pf, vf, o1, 0, 0, 0); }
            }
        }
#undef AT_SCORES
        lsum += __shfl_xor(lsum, 32);
        lsum += __builtin_amdgcn_exp2f(sink2 - mx);
        if (h == 0) wsf[r] = 1.0f / lsum;
        LDS_WAIT(); asm volatile("" ::: "memory");
        float gt0[16], gt1[16];
#pragma unroll
        for (int rr = 0; rr < 16; ++rr) { const bf16* gp = F.ZA() + (rowbase + qs + crow(rr, h)) * NATC + 768 + 64 * hd + r; gt0[rr] = bf2f(gp[0]); gt1[rr] = bf2f(gp[32]); }
#pragma unroll
        for (int rr = 0; rr < 16; ++rr) {
            const int ql = crow(rr, h); const float inv = wsf[ql];
            bf16* op = F.YMIX() + (rowbase + qs + ql) * DMODEL + DHY + 64 * hd + r;
            op[0] = (bf16)f2bf(o0[rr] * inv * gt0[rr]);
            op[32] = (bf16)f2bf(o1[rr] * inv * gt1[rr]);
        }
        LDS_WAIT(); asm volatile("" ::: "memory");
    }
}

__device__ __forceinline__ void p3_panel(Frame& F, int pm) {
    int tid = F.tid, lane = F.lane; const int wave = F.wave;
    asm volatile("" : "+v"(tid), "+v"(lane));
#ifndef P3_NO_A
    {
        const int ml = tid & 255, half = tid >> 8;
        const size_t m = (size_t)pm * 256 + ml;
#pragma unroll 4
        for (int oc = half * 32; oc < half * 32 + 32; ++oc) {
            const bf16* src = F.YT() + (size_t)(8 * oc) * MTOK + m;
            unsigned e[8];
#pragma unroll
            for (int i = 0; i < 8; ++i) e[i] = src[(size_t)i * MTOK];
            v4u w; w.x = e[0] | (e[1] << 16); w.y = e[2] | (e[3] << 16); w.z = e[4] | (e[5] << 16); w.w = e[6] | (e[7] << 16);
            *(v4u*)(F.YMIX() + m * DMODEL + 8 * oc) = w;
        }
    }
#endif
    VM_WAIT(); __syncthreads();
    {
        const bf16* w2 = F.W2T(); const bf16* ym = F.YMIX();
        asm volatile("" : "+s"(w2), "+s"(ym));
        pg8::Gemm g{ym, w2, MTOK, DMODEL, DMODEL}; pg8::PanelOrder S{pm, DMODEL / 256};
        pg8::EpiY E{F.YRAW(), DMODEL, F.SS()};
        pg8::gemm_phase<pg8::EpiY, pg8::PanelOrder, true, true>(F.lds, g, S, E);
    }
    VM_WAIT(); __syncthreads();
    asm volatile("" : "+v"(lane));
#ifndef P3_NO_C
    {
        f32x4 gq[4];
#pragma unroll
        for (int j = 0; j < 4; ++j) gq[j] = *((const f32x4*)F.post_g() + lane + 64 * j);
#pragma unroll 1
        for (int i = 0; i < 32; i += 4) {
            const size_t row0 = (size_t)pm * 256 + wave * 32 + i;
            float ss[4]; v2u yw[4][4]; f32x4 xv[4][4];
#pragma unroll
            for (int q = 0; q < 4; ++q) { const size_t row = row0 + q;
                ss[q] = (lane < 16) ? F.SS()[row * 16 + lane] : 0.f;
                const v2u* yr = (const v2u*)(F.YRAW() + row * DMODEL) + lane; const f32x4* xr = (const f32x4*)(F.x() + row * DMODEL) + lane;
#pragma unroll
                for (int j = 0; j < 4; ++j) { yw[q][j] = yr[64 * j]; xv[q][j] = xr[64 * j]; } }
#pragma unroll
            for (int o = 1; o < 16; o <<= 1) {
#pragma unroll
                for (int q = 0; q < 4; ++q) ss[q] += __shfl_xor(ss[q], o); }
#pragma unroll
            for (int q = 0; q < 4; ++q) { const float tot = __shfl(ss[q], 0); const float rstd = 1.0f / sqrtf(tot * (1.0f / DMODEL) + RMS_EPS);
                f32x4* orow = (f32x4*)(F.out() + (row0 + q) * DMODEL) + lane;
#pragma unroll
                for (int j = 0; j < 4; ++j) { const v2u y = yw[q][j]; const f32x4 x = xv[q][j];
                    f32x4 o; o.x = x.x + bflo(y.x) * rstd * gq[j].x; o.y = x.y + bfhi(y.x) * rstd * gq[j].y; o.z = x.z + bflo(y.y) * rstd * gq[j].z; o.w = x.w + bfhi(y.y) * rstd * gq[j].w;
                    orow[64 * j] = o; } }
        }
    }
#endif
    __syncthreads();
}

__global__ void __launch_bounds__(NTHREADS, 2) hybrid_fwd(Args args) {
    extern __shared__ __attribute__((aligned(16))) unsigned char lds_raw[];
    Frame F;
    F.lds = (LAS unsigned char*)lds_raw;
    F.tid = threadIdx.x; F.lane = F.tid & 63; F.wave = __builtin_amdgcn_readfirstlane(F.tid >> 6);
    F.G = gridDim.x; { const int bx = blockIdx.x; F.vcu = (F.G % 8 == 0) ? (bx % 8) * (F.G / 8) + bx / 8 : bx; }
    F.A = &args;
    const int lo = args.ph_lo, hi = args.ph_hi;
#define IN(k) (lo <= (k) && (k) < hi)
#define SEAM(k) do { if (IN(k) && IN((k) + 1)) { cg::this_grid().sync(); } } while (0)

#ifndef NO_P0
    if (IN(0)) { for (int rp_ = 0; rp_ < RPT_P0; ++rp_) p0_prologue(F); }
#endif
    SEAM(0);
#ifndef NO_P1
    if (IN(1)) for (int rp_ = 0; rp_ < RPT_P1; ++rp_) {
        { pg8::Gemm g{F.W1T(), F.XN(), NHYC, MTOK, DMODEL}; pg8::StaticOrder S; S.init(NHYC, MTOK, F.G, (int)blockIdx.x);
          pg8::EpiZT E{F.ZT(), MTOK};
          pg8::gemm_phase<pg8::EpiZT, pg8::StaticOrder, true, true>(F.lds, g, S, E); }
        { pg8::Gemm g{F.XN(), F.W1T() + (size_t)NHYC * DMODEL, MTOK, NATC, DMODEL}; pg8::StaticOrder S; S.init(MTOK, NATC, F.G, (int)blockIdx.x);
          pg8::EpiZA E{F.ZA(), NATC, QSCALE};
          pg8::gemm_phase<pg8::EpiZA, pg8::StaticOrder, true, true>(F.lds, g, S, E); }
    }
#endif
    SEAM(1);
    if (IN(2)) {
#ifndef NO_HY
        for (int rp_ = 0; rp_ < RPT_HY; ++rp_) for (int c = F.vcu; c < DHY; c += F.G) hyena_unit(F, c);
#endif
        const int nau = AT_UNITS, per = (nau + F.G - 1) / F.G;
#ifndef NO_AT
        for (int rp_ = 0; rp_ < RPT_AT; ++rp_) for (int i = 0; i < per; ++i) { const int u = F.vcu * per + i; if (u < nau) attn_unit(F, u); }
#endif
    }
    SEAM(2);
    if (IN(3)) {
#ifndef NO_P3
        for (int rp_ = 0; rp_ < RPT_P3; ++rp_) for (int pm = F.vcu; pm < MTOK / 256; pm += F.G) p3_panel(F, pm);
#endif
    }
#undef IN
#undef SEAM
}

extern "C" void kernel_launch(void* const* d_in, const int* in_sizes, int n_in, void* d_out, int out_size, void* d_ws, size_t ws_size, hipStream_t stream) {
    static int grid = 0;
    if (grid == 0) {
        if (n_in != 17 || in_sizes[0] != MTOK * DMODEL || out_size != MTOK * DMODEL || ws_size < WS_END) {
            fprintf(stderr, "kernel_launch: unexpected shapes (n_in %d, in0 %d, out %d, ws %zu); nothing launched\n", n_in, n_in > 0 ? in_sizes[0] : -1, out_size, ws_size); grid = -1; return; }
        int dev = 0, cus = 0, per_cu = 0;
        if (hipGetDevice(&dev) != hipSuccess || hipDeviceGetAttribute(&cus, hipDeviceAttributeMultiprocessorCount, dev) != hipSuccess) { fprintf(stderr, "kernel_launch: device query failed\n"); grid = -1; return; }
        if (hipFuncSetAttribute((const void*)hybrid_fwd, hipFuncAttributeMaxDynamicSharedMemorySize, LDS_BYTES) != hipSuccess) { fprintf(stderr, "kernel_launch: hipFuncSetAttribute failed\n"); grid = -1; return; }
        if (hipOccupancyMaxActiveBlocksPerMultiprocessor(&per_cu, (const void*)hybrid_fwd, NTHREADS, LDS_BYTES) != hipSuccess || per_cu < 1) {
            fprintf(stderr, "kernel_launch: occupancy query reports %d workgroups per CU; nothing launched\n", per_cu); (void)hipGetLastError(); grid = -1; return; }
        grid = cus;
    }
    if (grid < 0) return;
    Args a{};
    for (int i = 0; i < 17; ++i) a.in[i] = (const float*)d_in[i];
    a.out = (float*)d_out; a.ws = (unsigned char*)d_ws;
#if MK_N_LAUNCHES == 1
    a.ph_lo = 0; a.ph_hi = 4;
    void* kargs[] = {&a};
    const hipError_t e = hipLaunchCooperativeKernel((const void*)hybrid_fwd, dim3(grid), dim3(NTHREADS), kargs, LDS_BYTES, stream);
    if (e != hipSuccess) fprintf(stderr, "kernel_launch: cooperative launch failed: %s (grid %d)\n", hipGetErrorString(e), grid);
#else
    for (int p = 0; p < 4; ++p) {
        a.ph_lo = p; a.ph_hi = p + 1;
        hipLaunchKernelGGL(hybrid_fwd, dim3(grid), dim3(NTHREADS), LDS_BYTES, stream, a);
        const hipError_t le = hipPeekAtLastError();
        if (le != hipSuccess) { fprintf(stderr, "kernel_launch: launch %d failed: %s\n", p, hipGetErrorName(le)); break; }
    }
#endif
}
```

```cpp
#include <hip/hip_runtime.h>
#include <hip/hip_cooperative_groups.h>
#include <cstdio>
#include <cstdint>
namespace cg = cooperative_groups;

#define RPT_P0 1
#define RPT_P1 1
#define RPT_HY 1
#define RPT_AT 1
#define RPT_P3 1
#define RPT_HY_TBL 1
#define RPT_HY_STG 1
#define RPT_HY_EPI 1
#define RPT_P3_A 1
#define RPT_P3_C 1
#define MK_XCD_BARRIER 1
#define MK_COOP 1
#ifndef MK_N_LAUNCHES
#define MK_N_LAUNCHES 1
#endif

namespace pg8 {
#define PG8_LAS __attribute__((address_space(3)))
typedef unsigned short bf16_t;
typedef short bf16x8 __attribute__((ext_vector_type(8)));
typedef float f32x4 __attribute__((ext_vector_type(4)));
typedef unsigned u32x4 __attribute__((ext_vector_type(4)));
constexpr int BM = 256, BK = 64, HALF = 128, HTB = HALF * BK * 2  , STAGE_BYTES = 8 * HTB, NXCD = 8, WGM = 8;

__host__ __device__ __forceinline__ int lds_byte(int r, int c) { const int st = (r >> 4) * 2 + (c >> 5), rr = r & 15, cc = c & 31, ob = rr * 64 + cc * 2; return st * 1024 + (ob ^ (((ob >> 9) & 1) << 5)); }
__host__ __device__ __forceinline__ void stage_rc(int b, int& R, int& C) { const int st = b / 1024, sb = b % 1024, swz = sb ^ (((sb >> 9) & 1) << 5); R = (st >> 1) * 16 + swz / 64; C = (st & 1) * 32 + (swz % 64) / 2; }
__host__ __device__ __forceinline__ int perm32(int rho) { const int n = rho >> 4, i = rho & 15; return 8 * (i >> 2) + 4 * n + (i & 3); }

struct Unit { int pm, pn; };
struct Gemm { const bf16_t* A; const bf16_t* Bt; int M, N, K; };

struct StaticOrder {
    int nM, nN, nwg, G, c;
    __host__ __device__ void init(int M, int N, int G_, int c_) { nM = M / BM; nN = N / BM; nwg = nM * nN; G = G_; c = c_; }
    __host__ __device__ bool next(int i, Unit& u) const {
        const long L = (long)i * G + c; if (L >= nwg) return false;
        int wgid = (int)L; { const int q = nwg / NXCD, r = nwg % NXCD, xcd = wgid % NXCD, off = wgid / NXCD; wgid = (xcd < r ? xcd * (q + 1) : r * (q + 1) + (xcd - r) * q) + off; }
        const int nig = WGM * nN, gid = wgid / nig, fm = gid * WGM, gsz = (nM - fm) < WGM ? (nM - fm) : WGM;
        u.pm = fm + ((wgid % nig) % gsz); u.pn = (wgid % nig) / gsz; return true;
    }
    __device__ __forceinline__ void a_ready(const Unit&) const {}
    __device__ __forceinline__ void done(const Unit&) const {}
};
struct PanelOrder {
    int pm, ntn;
    __device__ bool next(int i, Unit& u) const { if (i >= ntn) return false; u.pm = pm; u.pn = i; return true; }
    __device__ __forceinline__ void a_ready(const Unit&) const {}
    __device__ __forceinline__ void done(const Unit&) const {}
};

typedef float f32x2 __attribute__((ext_vector_type(2))); typedef __bf16 bf16x2_t __attribute__((ext_vector_type(2)));
__device__ __forceinline__ unsigned cvt_pk_bf16(float lo, float hi) { f32x2 v = {lo, hi}; bf16x2_t b = __builtin_convertvector(v, bf16x2_t); return __builtin_bit_cast(unsigned, b); }
__device__ __forceinline__ float silu_f(float v) { return v * __builtin_amdgcn_rcpf(1.0f + __expf(-v)); }
__device__ __forceinline__ f32x4 silu4(f32x4 v) { return (f32x4){silu_f(v[0]), silu_f(v[1]), silu_f(v[2]), silu_f(v[3])}; }

struct EpiZT {
    static constexpr bool PERM = true, AFTER_DRAIN = false;
    bf16_t* O; int ldc;
    __device__ __forceinline__ void operator()(const f32x4 (&acc)[2][2][4][2], const Unit& u, int wr, int wc, int fr, int fq) const {
        const int row0 = u.pm * BM + wr * 64 + fr, col0 = u.pn * BM + wc * 32 + 8 * fq; const bool act = (u.pm >= 6);
#pragma unroll
        for (int ai = 0; ai < 2; ++ai)
#pragma unroll
            for (int m = 0; m < 4; ++m) { bf16_t* rowp = O + (size_t)(row0 + ai * HALF + m * 16) * ldc + col0;
#pragma unroll
                for (int bj = 0; bj < 2; ++bj) { f32x4 v0 = acc[ai][bj][m][0], v1 = acc[ai][bj][m][1];
                    if (act) { v0 = silu4(v0); v1 = silu4(v1); }
                    u32x4 w; w.x = cvt_pk_bf16(v0[0], v0[1]); w.y = cvt_pk_bf16(v0[2], v0[3]); w.z = cvt_pk_bf16(v1[0], v1[1]); w.w = cvt_pk_bf16(v1[2], v1[3]);
                    *(u32x4*)(rowp + bj * HALF) = w; } }
    }
};
struct EpiZA {
    static constexpr bool PERM = true, AFTER_DRAIN = false;
    bf16_t* O; int ldc; float qscale;
    __device__ __forceinline__ void operator()(const f32x4 (&acc)[2][2][4][2], const Unit& u, int wr, int wc, int fr, int fq) const {
        const int row0 = u.pm * BM + wr * 64 + fr, col0 = u.pn * BM + wc * 32 + 8 * fq; const bool act = (u.pn >= 3); const float sc = (u.pn < 2) ? qscale : 1.0f;
#pragma unroll
        for (int ai = 0; ai < 2; ++ai)
#pragma unroll
            for (int m = 0; m < 4; ++m) { bf16_t* rowp = O + (size_t)(row0 + ai * HALF + m * 16) * ldc + col0;
#pragma unroll
                for (int bj = 0; bj < 2; ++bj) { f32x4 v0 = acc[ai][bj][m][0], v1 = acc[ai][bj][m][1];
                    if (act) { v0 = silu4(v0); v1 = silu4(v1); }
                    v0 = v0 * sc; v1 = v1 * sc;
                    u32x4 w; w.x = cvt_pk_bf16(v0[0], v0[1]); w.y = cvt_pk_bf16(v0[2], v0[3]); w.z = cvt_pk_bf16(v1[0], v1[1]); w.w = cvt_pk_bf16(v1[2], v1[3]);
                    *(u32x4*)(rowp + bj * HALF) = w; } }
    }
};
struct EpiY {
    static constexpr bool PERM = true, AFTER_DRAIN = false;
    bf16_t* O; int ldc; float* SS;
    __device__ __forceinline__ void operator()(const f32x4 (&acc)[2][2][4][2], const Unit& u, int wr, int wc, int fr_in, int fq) const {
        int fr = fr_in; asm volatile("" : "+v"(fr));
        const int row0 = u.pm * BM + wr * 64 + fr, col0 = u.pn * BM + wc * 32 + 8 * fq;
#pragma unroll
        for (int ai = 0; ai < 2; ++ai)
#pragma unroll
            for (int m = 0; m < 4; ++m) { const int row = row0 + ai * HALF + m * 16; bf16_t* rowp = O + (size_t)row * ldc + col0; float s = 0.f;
#pragma unroll
                for (int bj = 0; bj < 2; ++bj) { const f32x4 v0 = acc[ai][bj][m][0], v1 = acc[ai][bj][m][1];
                    s += (v0[0] * v0[0] + v0[1] * v0[1]) + (v0[2] * v0[2] + v0[3] * v0[3]) + (v1[0] * v1[0] + v1[1] * v1[1]) + (v1[2] * v1[2] + v1[3] * v1[3]);
                    u32x4 w; w.x = cvt_pk_bf16(v0[0], v0[1]); w.y = cvt_pk_bf16(v0[2], v0[3]); w.z = cvt_pk_bf16(v1[0], v1[1]); w.w = cvt_pk_bf16(v1[2], v1[3]);
                    *(u32x4*)(rowp + bj * HALF) = w; }
                s += __shfl_xor(s, 16); s += __shfl_xor(s, 32);
                if (fq == 0) SS[(size_t)row * 16 + u.pn * 4 + wc] = s;
                asm volatile("" ::: "memory"); }
    }
};

template <class Epi, class Sched, bool ALIGN_EPI = false, bool SP2 = false>
__device__ __forceinline__ void gemm_phase(PG8_LAS unsigned char* lds, const Gemm g, const Sched& S, const Epi& E) {
    int tid_l = threadIdx.x; asm volatile("" : "+v"(tid_l));
    const int tid = tid_l, wid = __builtin_amdgcn_readfirstlane(tid >> 6), lane = tid & 63, wr = wid >> 2, wc = wid & 3, fr = lane & 15, fq = lane >> 4;
    const int K = g.K, nt = K / BK;
    unsigned voffA[2], voffB[2];
#pragma unroll
    for (int i = 0; i < 2; ++i) { int R, C; stage_rc(tid * 16 + i * 8192, R, C); const int Rb = Epi::PERM ? ((R & ~31) + perm32(R & 31)) : R;
        voffA[i] = (unsigned)(R * K + C) * 2u; voffB[i] = (unsigned)(Rb * K + C) * 2u; }
    const size_t kstep = (size_t)(BK * 2);
    const size_t hstep = (size_t)HALF * K * 2;
    const size_t tstep = 2 * hstep;
    const unsigned ldsw = (unsigned)wid * 1024u;
    const int aoff = lds_byte(wr * 64 + fr, fq * 8), boff = lds_byte(wc * 32 + fr, fq * 8);
#define PG8_SA(b, h) (((b) * 2 + (h)) * HTB)
#define PG8_SB(b, h) ((4 + (b) * 2 + (h)) * HTB)
#define PG8_STAGE(bufoff, gbase, voff) do { _Pragma("unroll") for (int _i = 0; _i < 2; ++_i) \
        __builtin_amdgcn_global_load_lds((const unsigned*)((const char*)(gbase) + (voff)[_i]), (PG8_LAS unsigned*)(lds + (bufoff) + ldsw + _i * 8192), 16, 0, 0); } while (0)
#define PG8_LDA(dst, b, h) do { _Pragma("unroll") for (int m = 0; m < 4; ++m) _Pragma("unroll") for (int k = 0; k < 2; ++k) dst[m][k] = *(const PG8_LAS bf16x8*)(lds + PG8_SA(b, h) + aoff + m * 2048 + k * 1024); } while (0)
#define PG8_LDB(dst, b, h) do { _Pragma("unroll") for (int n = 0; n < 2; ++n) _Pragma("unroll") for (int k = 0; k < 2; ++k) dst[n][k] = *(const PG8_LAS bf16x8*)(lds + PG8_SB(b, h) + boff + n * 2048 + k * 1024); } while (0)
#define PG8_MMA(ai, bj, At, Bt) do { __builtin_amdgcn_s_setprio(1); _Pragma("unroll") for (int m = 0; m < 4; ++m) _Pragma("unroll") for (int n = 0; n < 2; ++n) _Pragma("unroll") for (int k = 0; k < 2; ++k) \
        acc[ai][bj][m][n] = __builtin_amdgcn_mfma_f32_16x16x32_bf16(Bt[n][k], At[m][k], acc[ai][bj][m][n], 0, 0, 0); __builtin_amdgcn_s_setprio(0); } while (0)
#define PG8_WAIT_V(n) asm volatile("s_waitcnt vmcnt(" #n ")" ::: "memory")
#define PG8_WAIT_L(n) asm volatile("s_waitcnt lgkmcnt(" #n ")" ::: "memory")
#define PG8_BAR __builtin_amdgcn_s_barrier()
#define PG8_SCHED __builtin_amdgcn_sched_barrier(0)
    Unit cur, nxt; int ui = 0;
    if (!S.next(0, cur)) return;
    f32x4 acc[2][2][4][2];
#pragma unroll
    for (int a = 0; a < 2; ++a)
#pragma unroll
        for (int b = 0; b < 2; ++b)
#pragma unroll
            for (int m = 0; m < 4; ++m)
#pragma unroll
                for (int n = 0; n < 2; ++n) acc[a][b][m][n] = (f32x4){0.f, 0.f, 0.f, 0.f};
    bf16x8 At[4][2], B0[2][2], B1[2][2];
    const char* cA = (const char*)g.A + (size_t)cur.pm * tstep; const char* cB = (const char*)g.Bt + (size_t)cur.pn * tstep;
    S.a_ready(cur);
    if constexpr (SP2) {
        PG8_STAGE(PG8_SB(0, 0), cB, voffB); PG8_STAGE(PG8_SB(0, 1), cB + hstep, voffB); PG8_STAGE(PG8_SA(0, 0), cA, voffA); PG8_STAGE(PG8_SA(0, 1), cA + hstep, voffA);
        if (wr == 1) PG8_BAR;
        PG8_WAIT_V(2); PG8_BAR;
        PG8_STAGE(PG8_SB(1, 0), cB + kstep, voffB); PG8_STAGE(PG8_SA(1, 0), cA + kstep, voffA); PG8_STAGE(PG8_SB(1, 1), cB + hstep + kstep, voffB);
        PG8_WAIT_V(6); PG8_BAR;
    } else {
        PG8_STAGE(PG8_SB(0, 0), cB, voffB); PG8_STAGE(PG8_SA(0, 0), cA, voffA); PG8_STAGE(PG8_SB(0, 1), cB + hstep, voffB); PG8_STAGE(PG8_SA(0, 1), cA + hstep, voffA);
        if (wr == 1) PG8_BAR;
        PG8_WAIT_V(4); PG8_BAR;
        PG8_STAGE(PG8_SB(1, 0), cB + kstep, voffB); PG8_STAGE(PG8_SA(1, 0), cA + kstep, voffA); PG8_STAGE(PG8_SB(1, 1), cB + hstep + kstep, voffB);
        PG8_WAIT_V(6); PG8_BAR;
    }
    for (;;) {
        const bool has_next = S.next(ui + 1, nxt);
        const char* nA = has_next ? (const char*)g.A + (size_t)nxt.pm * tstep : cA; const char* nB = has_next ? (const char*)g.Bt + (size_t)nxt.pn * tstep : cB;
        for (int t = 0; t < nt; t += 2) {
            const bool last = (t == nt - 2);
            const char* a1 = cA + (size_t)(t + 1) * kstep;
            const char* a2 = last ? nA : cA + (size_t)(t + 2) * kstep; const char* b2 = last ? nB : cB + (size_t)(t + 2) * kstep;
            const char* a3 = a2 + kstep; const char* b3 = b2 + kstep;
            if (last && has_next) S.a_ready(nxt);
            if constexpr (SP2) {
            PG8_LDB(B0, 0, 0); PG8_LDB(B1, 0, 1); PG8_SCHED; PG8_LDA(At, 0, 0); PG8_STAGE(PG8_SA(1, 1), a1 + hstep, voffA);
            PG8_WAIT_V(8); PG8_WAIT_L(0); PG8_BAR; PG8_MMA(0, 0, At, B0); PG8_MMA(0, 1, At, B1); PG8_BAR; PG8_SCHED;
            PG8_LDA(At, 0, 1); PG8_STAGE(PG8_SB(0, 0), b2, voffB); PG8_STAGE(PG8_SB(0, 1), b2 + hstep, voffB); PG8_STAGE(PG8_SA(0, 0), a2, voffA);
            PG8_WAIT_V(8); PG8_WAIT_L(0); PG8_BAR; PG8_MMA(1, 0, At, B0); PG8_MMA(1, 1, At, B1); PG8_BAR; PG8_SCHED;
            PG8_LDB(B0, 1, 0); PG8_LDB(B1, 1, 1); PG8_SCHED; PG8_LDA(At, 1, 0); PG8_STAGE(PG8_SA(0, 1), a2 + hstep, voffA);
            PG8_WAIT_V(8); PG8_WAIT_L(0); PG8_BAR; PG8_MMA(0, 0, At, B0); PG8_MMA(0, 1, At, B1); PG8_BAR; PG8_SCHED;
            PG8_LDA(At, 1, 1); PG8_STAGE(PG8_SB(1, 0), b3, voffB); PG8_STAGE(PG8_SB(1, 1), b3 + hstep, voffB); PG8_STAGE(PG8_SA(1, 0), a3, voffA);
            PG8_WAIT_V(8); PG8_WAIT_L(0); PG8_BAR; PG8_MMA(1, 0, At, B0); PG8_MMA(1, 1, At, B1); PG8_BAR; PG8_SCHED;
            } else {
            PG8_LDB(B0, 0, 0); PG8_SCHED; PG8_LDA(At, 0, 0); PG8_STAGE(PG8_SA(1, 1), a1 + hstep, voffA);
            PG8_WAIT_L(8); PG8_BAR; PG8_WAIT_L(0); PG8_MMA(0, 0, At, B0); PG8_BAR; PG8_SCHED;
            PG8_LDB(B1, 0, 1); PG8_STAGE(PG8_SB(0, 0), b2, voffB);
            PG8_BAR; PG8_WAIT_L(0); PG8_MMA(0, 1, At, B1); PG8_BAR;
            PG8_LDA(At, 0, 1); PG8_STAGE(PG8_SA(0, 0), a2, voffA);
            PG8_BAR; PG8_WAIT_L(0); PG8_MMA(1, 0, At, B0); PG8_BAR; PG8_SCHED;
            PG8_STAGE(PG8_SB(0, 1), b2 + hstep, voffB);
            PG8_WAIT_V(6); PG8_BAR; PG8_MMA(1, 1, At, B1); PG8_BAR;
            PG8_LDB(B0, 1, 0); PG8_SCHED; PG8_LDA(At, 1, 0); PG8_STAGE(PG8_SA(0, 1), a2 + hstep, voffA);
            PG8_WAIT_L(8); PG8_BAR; PG8_WAIT_L(0); PG8_MMA(0, 0, At, B0); PG8_BAR; PG8_SCHED;
            PG8_LDB(B1, 1, 1); PG8_STAGE(PG8_SB(1, 0), b3, voffB);
            PG8_BAR; PG8_WAIT_L(0); PG8_MMA(0, 1, At, B1); PG8_BAR;
            PG8_LDA(At, 1, 1); PG8_STAGE(PG8_SA(1, 0), a3, voffA);
            PG8_BAR; PG8_WAIT_L(0); PG8_MMA(1, 0, At, B0); PG8_BAR; PG8_SCHED;
            PG8_STAGE(PG8_SB(1, 1), b3 + hstep, voffB);
            PG8_WAIT_V(6); PG8_BAR; PG8_MMA(1, 1, At, B1); PG8_BAR;
            }
        }
        if constexpr (ALIGN_EPI) { if (wr == 0) PG8_BAR; }
        if constexpr (!Epi::AFTER_DRAIN) { E(acc, cur, wr, wc, fr, fq); S.done(cur); }
        if (!has_next) break;
#pragma unroll
        for (int a = 0; a < 2; ++a)
#pragma unroll
            for (int b = 0; b < 2; ++b)
#pragma unroll
                for (int m = 0; m < 4; ++m)
#pragma unroll
                    for (int n = 0; n < 2; ++n) acc[a][b][m][n] = (f32x4){0.f, 0.f, 0.f, 0.f};
        cur = nxt; cA = nA; cB = nB; ++ui;
        if constexpr (ALIGN_EPI) { if (wr == 1) PG8_BAR; }
    }
    PG8_WAIT_V(0);
    if constexpr (!ALIGN_EPI) { if (wr == 0) PG8_BAR; }
    PG8_BAR;
    if constexpr (Epi::AFTER_DRAIN) { E.fused(acc, cur, wr, wc, fr, fq, lds, wid, lane); S.done(cur); }
#undef PG8_SA
#undef PG8_SB
#undef PG8_STAGE
#undef PG8_LDA
#undef PG8_LDB
#undef PG8_MMA
#undef PG8_WAIT_V
#undef PG8_WAIT_L
#undef PG8_BAR
#undef PG8_SCHED
}
}

constexpr int NWAVES = 8, NTHREADS = 512;
constexpr int BATCH = 32, SEQ = 2048, DMODEL = 1024, MTOK = BATCH * SEQ;
constexpr int DHY = 512, NHYC = 2048  , NATC = 1280  , NIN = 3328;
constexpr int NHEADS = 8, HD = 64, WIN = 128;
constexpr float RMS_EPS = 1e-6f, LOG2E = 1.4426950408889634f;
constexpr float QSCALE = 0.125f * LOG2E;

constexpr size_t MiB = 1u << 20;
constexpr size_t WS_W1T = 2 * MiB;
constexpr size_t WS_W2T = 10 * MiB;
constexpr size_t WS_FRAW = 12 * MiB;
constexpr size_t WS_SS = 20 * MiB;
constexpr size_t WS_XN = 32 * MiB;
constexpr size_t WS_ZT = 160 * MiB;
constexpr size_t WS_ZA = 416 * MiB;
constexpr size_t WS_YT = 576 * MiB;
constexpr size_t WS_YMIX = 640 * MiB;
constexpr size_t WS_YRAW = 768 * MiB;
constexpr size_t WS_END = 896 * MiB;

constexpr int LDS_BYTES = 147456;

#define LAS __attribute__((address_space(3)))
typedef unsigned short bf16;
typedef unsigned v4u __attribute__((ext_vector_type(4)));
typedef unsigned v2u __attribute__((ext_vector_type(2)));
typedef float f32x4 __attribute__((ext_vector_type(4)));
typedef float f32x16 __attribute__((ext_vector_type(16)));
typedef short bf16x8 __attribute__((ext_vector_type(8)));
typedef short s16x4 __attribute__((ext_vector_type(4)));
#define LDS_WAIT() asm volatile("s_waitcnt lgkmcnt(0)" ::: "memory")
#define VM_WAIT() asm volatile("s_waitcnt vmcnt(0)" ::: "memory")
__device__ __forceinline__ unsigned f2bf(float f) { unsigned u = __builtin_bit_cast(unsigned, f); return (u + 0x7fffu + ((u >> 16) & 1u)) >> 16; }
__device__ __forceinline__ unsigned pk2(float lo, float hi) { return pg8::cvt_pk_bf16(lo, hi); }
__device__ __forceinline__ float bf2f(unsigned u16) { return __uint_as_float(u16 << 16); }
__device__ __forceinline__ float bflo(unsigned w) { return __uint_as_float(w << 16); }
__device__ __forceinline__ float bfhi(unsigned w) { return __uint_as_float(w & 0xffff0000u); }
__device__ __forceinline__ int crow(int r, int hi) { return (r & 3) + 8 * (r >> 2) + 4 * hi; }
__device__ __forceinline__ float wave_sum(float v) {
#pragma unroll
    for (int o = 1; o < 64; o <<= 1) v += __shfl_xor(v, o);
    return v;
}

struct Args { const float* in[17]; float* out; unsigned char* ws; int ph_lo, ph_hi; };
struct Frame {
    LAS unsigned char* lds;
    int tid, lane, wave, vcu, G;
    const Args* A;
#define FRAME_IN(name, k) __device__ __forceinline__ const float* name() const { return A->in[k]; }
    FRAME_IN(x, 0) FRAME_IN(pre_g, 1) FRAME_IN(w_in, 2) FRAME_IN(w_short, 3) FRAME_IN(b_short, 4) FRAME_IN(w_f1, 5) FRAME_IN(b_f1, 6) FRAME_IN(w_f2, 7) FRAME_IN(b_f2, 8)
    FRAME_IN(w_f3, 9) FRAME_IN(b_f3, 10) FRAME_IN(w_f4, 11) FRAME_IN(sin_freq, 12) FRAME_IN(hyena_d, 13) FRAME_IN(attn_sink, 14) FRAME_IN(w_out, 15) FRAME_IN(post_g, 16)
#undef FRAME_IN
    __device__ __forceinline__ float* out() const { return A->out; }
#define FRAME_WS(type, name, off) __device__ __forceinline__ type* name() const { return (type*)(A->ws + (off)); }
    FRAME_WS(bf16, W1T, WS_W1T) FRAME_WS(bf16, W2T, WS_W2T) FRAME_WS(float, FRAW, WS_FRAW) FRAME_WS(float, SS, WS_SS) FRAME_WS(bf16, XN, WS_XN)
    FRAME_WS(bf16, ZT, WS_ZT) FRAME_WS(bf16, ZA, WS_ZA) FRAME_WS(bf16, YT, WS_YT) FRAME_WS(bf16, YMIX, WS_YMIX) FRAME_WS(bf16, YRAW, WS_YRAW)
#undef FRAME_WS
};

__device__ __forceinline__ float sin_rev(float x) { const float rv = x * 0.15915494309189535f; return __builtin_amdgcn_sinf(rv - floorf(rv)); }
__device__ __forceinline__ float cos_rev(float x) { const float rv = x * 0.15915494309189535f; return __builtin_amdgcn_cosf(rv - floorf(rv)); }
__device__ __forceinline__ void p0_transpose_item(const float* W, int K, int N, bf16* WT, const float* gk, LAS float* scr, int item, int lane) {
    const int nblk = N / 32, kb = item / nblk, nb = item % nblk, k0 = 64 * kb, n0 = 32 * nb;
#pragma unroll 8
    for (int i = 0; i < 32; ++i) { const int kk = 2 * i + (lane >> 5); scr[kk * 33 + (lane & 31)] = W[(size_t)(k0 + kk) * N + n0 + (lane & 31)]; }
    LDS_WAIT(); asm volatile("" ::: "memory");
    const int c = lane & 7;
    float g8[8];
#pragma unroll
    for (int i = 0; i < 8; ++i) g8[i] = gk ? gk[k0 + 8 * c + i] : 1.0f;
#pragma unroll
    for (int j = 0; j < 4; ++j) { const int n = (lane >> 3) + 8 * j; const LAS float* s = scr + (8 * c) * 33 + n;
        v4u o; o.x = pk2(s[0 * 33] * g8[0], s[1 * 33] * g8[1]); o.y = pk2(s[2 * 33] * g8[2], s[3 * 33] * g8[3]); o.z = pk2(s[4 * 33] * g8[4], s[5 * 33] * g8[5]); o.w = pk2(s[6 * 33] * g8[6], s[7 * 33] * g8[7]);
        *(v4u*)(WT + (size_t)(n0 + n) * K + k0 + 8 * c) = o; }
    LDS_WAIT(); asm volatile("" ::: "memory");
}
__device__ __forceinline__ void rms_rows4_to_bf16(const float* x0, bf16* o0, int lane) {
    f32x4 v[4][4]; float s[4];
#pragma unroll
    for (int q = 0; q < 4; ++q) { const f32x4* xr = (const f32x4*)(x0 + (size_t)q * DMODEL) + lane;
#pragma unroll
        for (int j = 0; j < 4; ++j) v[q][j] = xr[64 * j]; }
#pragma unroll
    for (int q = 0; q < 4; ++q) { float a = 0.f;
#pragma unroll
        for (int j = 0; j < 4; ++j) a += (v[q][j].x * v[q][j].x + v[q][j].y * v[q][j].y) + (v[q][j].z * v[q][j].z + v[q][j].w * v[q][j].w);
        s[q] = a; }
#pragma unroll
    for (int o = 1; o < 64; o <<= 1) {
#pragma unroll
        for (int q = 0; q < 4; ++q) s[q] += __shfl_xor(s[q], o); }
#pragma unroll
    for (int q = 0; q < 4; ++q) { const float rstd = 1.0f / sqrtf(s[q] * (1.0f / DMODEL) + RMS_EPS);
        v2u* o8 = (v2u*)(o0 + (size_t)q * DMODEL) + lane;
#pragma unroll
        for (int j = 0; j < 4; ++j) { v2u w; w.x = pk2(v[q][j].x * rstd, v[q][j].y * rstd); w.y = pk2(v[q][j].z * rstd, v[q][j].w * rstd); o8[64 * j] = w; } }
}
__device__ __forceinline__ void p0_filter_item(Frame& F, int item) {
    const int lane = F.lane, wave = F.wave, t = 8 * item + wave;
    LAS float* zs = (LAS float*)(F.lds + wave * 16384);
    LAS float* fo = (LAS float*)(F.lds + wave * 16384 + 4096);
    const float tn = (float)t / 2047.0f;
    const float w = (6.2831855f * (float)t) / 2048.0f;
    {
        float z = 0.f;
        if (lane == 0) z = tn;
        else if (lane <= 32) {
            const int i = (lane - 1) & 15;
            const float band = (float)(1e-4 + (double)i * ((15.0 - 1e-4) / 15.0));
            const float ang = w * band;
            z = (lane <= 16) ? cos_rev(ang) : -sin_rev(ang);
        }
        zs[lane] = z;
    }
    __syncthreads();
    {
        float a = 0.f;
#pragma unroll 3
        for (int k = 0; k < 33; ++k) a += zs[k] * F.w_f1()[k * 64 + lane];
        a += F.b_f1()[lane];
        zs[64 + lane] = sin_rev(F.sin_freq()[lane] * a);
    }
    __syncthreads();
    {
        float a = 0.f;
#pragma unroll 4
        for (int k = 0; k < 64; ++k) a += zs[64 + k] * F.w_f2()[k * 64 + lane];
        a += F.b_f2()[lane];
        zs[128 + lane] = sin_rev(F.sin_freq()[64 + lane] * a);
    }
    __syncthreads();
    {
        float a = 0.f;
#pragma unroll 4
        for (int k = 0; k < 64; ++k) a += zs[128 + k] * F.w_f3()[k * 64 + lane];
        a += F.b_f3()[lane];
        zs[192 + lane] = sin_rev(F.sin_freq()[128 + lane] * a);
    }
    __syncthreads();
    {
        float a[16];
#pragma unroll
        for (int j = 0; j < 16; ++j) a[j] = 0.f;
#pragma unroll 2
        for (int k = 0; k < 64; ++k) { const float hk = zs[192 + k]; const float* wr = F.w_f4() + (size_t)k * 1024 + lane;
#pragma unroll
            for (int j = 0; j < 16; ++j) a[j] += hk * wr[64 * j]; }
        const double min_decay = -4.605170185988091 / 1.5, max_decay = -4.605170185988091 / 0.3;
#pragma unroll
        for (int j = 0; j < 16; ++j) { const int col = lane + 64 * j, c = col & 511;
            double dl = min_decay + (double)c * ((max_decay - min_decay) / 511.0); if (c == 511) dl = max_decay;
            const float delta = (float)(dl < 0 ? -dl : dl);
            fo[col] = a[j] * expf(-(tn * delta)); }
    }
    __syncthreads();
    {
        const int tid = F.tid;
#pragma unroll
        for (int cc = 0; cc < 2; ++cc) { const int col = tid + 512 * cc; float v[8];
#pragma unroll
            for (int p = 0; p < 8; ++p) v[p] = *(const LAS float*)(F.lds + p * 16384 + 4096 + col * 4);
            f32x4* dst = (f32x4*)(F.FRAW() + (size_t)col * SEQ + 8 * item);
            dst[0] = (f32x4){v[0], v[1], v[2], v[3]}; dst[1] = (f32x4){v[4], v[5], v[6], v[7]}; }
    }
    __syncthreads();
}
__device__ __forceinline__ void p0_prologue(Frame& F) {
    LAS float* scr = (LAS float*)(F.lds + F.wave * 16384);
    const int gw = F.vcu * NWAVES + F.wave, NGW = F.G * NWAVES;
    constexpr int I1 = (DMODEL / 64) * (NIN / 32), I2 = (DMODEL / 64) * (DMODEL / 32);
    for (int it = gw; it < I1 + I2; it += NGW) {
        if (it < I1) p0_transpose_item(F.w_in(), DMODEL, NIN, F.W1T(), F.pre_g(), scr, it, F.lane);
        else p0_transpose_item(F.w_out(), DMODEL, DMODEL, F.W2T(), nullptr, scr, it - I1, F.lane);
    }
    for (int m4 = gw; m4 < MTOK / 4; m4 += NGW) rms_rows4_to_bf16(F.x() + (size_t)m4 * 4 * DMODEL, F.XN() + (size_t)m4 * 4 * DMODEL, F.lane);
    __syncthreads();
    for (int it = F.vcu; it < SEQ / 8; it += F.G) p0_filter_item(F, it);
}

constexpr int HY_CS = 8256;
constexpr int HY_TBL = 0, HY_VB = 8 * HY_CS;
constexpr int HY_VSTR = 2064;
constexpr int HY_SCW = 32 * 132 * 4;
static_assert(HY_VB + 32 * HY_VSTR <= LDS_BYTES && 8 * HY_SCW <= LDS_BYTES, "hyena LDS map");

__device__ __forceinline__ void conv8(float (&o)[8], const v4u c, float left, float right, float w0, float w1, float w2, float bias) {
    float e[10]; e[0] = left; e[9] = right;
    e[1] = bflo(c.x); e[2] = bfhi(c.x); e[3] = bflo(c.y); e[4] = bfhi(c.y); e[5] = bflo(c.z); e[6] = bfhi(c.z); e[7] = bflo(c.w); e[8] = bfhi(c.w);
#pragma unroll
    for (int j = 0; j < 8; ++j) o[j] = ((e[j] * w0 + e[j + 1] * w1) + e[j + 2] * w2) + bias;
}

__device__ __forceinline__ void hyena_unit(Frame& F, int c) {
    int tid = F.tid; asm volatile("" : "+v"(tid));
    const int lane = tid & 63, wave = F.wave, r = lane & 31, h = lane >> 5;
    LAS unsigned char* lds = F.lds;
    __syncthreads();
    for (int rp_ = 0; rp_ < RPT_HY_TBL; ++rp_) { if (rp_) __syncthreads();
        const float* ff = F.FRAW() + (size_t)c * SEQ; const float* fb = F.FRAW() + (size_t)(DHY + c) * SEQ;
        float rv[8]; float ssq = 0.f;
#pragma unroll
        for (int j = 0; j < 8; ++j) { const int n = tid + 512 * j; float v = 0.f;
            if (n <= 2047) v = ff[2047 - n]; else if (n <= 4094) v = fb[n - 2047];
            rv[j] = v; ssq += v * v; }
        ssq = wave_sum(ssq);
        LAS float* red = (LAS float*)(lds + HY_VB);
        if (lane == 0) red[wave] = ssq;
        __syncthreads();
        float tot = 0.f;
#pragma unroll
        for (int i = 0; i < 8; ++i) tot += red[i];
        const float scale = 1.0f / sqrtf(tot + 1e-12f);
#pragma unroll
        for (int j = 0; j < 8; ++j) { const int n = tid + 512 * j; const unsigned short bfv = (unsigned short)f2bf(rv[j] * scale);
#pragma unroll
            for (int q = 0; q < 8; ++q) { const int m = n - q; if (m >= 0) *(LAS unsigned short*)(lds + HY_TBL + q * HY_CS + 2 * m) = bfv; } }
    }
    const float wx0_0 = F.w_short()[c], wx0_1 = F.w_short()[1536 + c], wx0_2 = F.w_short()[3072 + c], bx0 = F.b_short()[c];
    const float wx1_0 = F.w_short()[DHY + c], wx1_1 = F.w_short()[1536 + DHY + c], wx1_2 = F.w_short()[3072 + DHY + c], bx1 = F.b_short()[DHY + c];
    const float wv_0 = F.w_short()[2 * DHY + c], wv_1 = F.w_short()[1536 + 2 * DHY + c], wv_2 = F.w_short()[3072 + 2 * DHY + c], bv = F.b_short()[2 * DHY + c];
    const float dskip = F.hyena_d()[c];
    const bf16* x0row = F.ZT() + (size_t)c * MTOK; const bf16* x1row = F.ZT() + (size_t)(DHY + c) * MTOK;
    const bf16* vrow = F.ZT() + (size_t)(2 * DHY + c) * MTOK; const bf16* grow = F.ZT() + (size_t)(3 * DHY + c) * MTOK;

    f32x16 acc[8];
#pragma unroll
    for (int i = 0; i < 8; ++i) acc[i] = f32x16{};
    bf16x8 fr[16];
    const int q = 7 - (r & 7);
    const int abase = HY_TBL + q * HY_CS + 4080 - 16 * (r >> 3) + 16 * h;
    const int bbase = HY_VB + r * HY_VSTR + 16 * h;
#define HY_LDA(a) (*(const LAS bf16x8*)(lds + abase - 32 * (a)))
#pragma unroll 1
    for (int ch = 0; ch < 2; ++ch) {
        __syncthreads();
#pragma unroll 1
        for (int itg = 0; itg < 2 * RPT_HY_STG; ++itg) {
            v4u c1[4], cv[4]; unsigned hl1[4], hr1[4], hlv[4], hrv[4];
#pragma unroll
            for (int u = 0; u < 4; ++u) {
                const int idx = ((itg & 1) * 4 + u) * 512 + tid, b = idx >> 7, sg = idx & 127, s = ch * 1024 + 8 * sg;
                const bf16* p1 = x1row + b * SEQ + s; const bf16* pv = vrow + b * SEQ + s;
                c1[u] = *(const v4u*)p1; cv[u] = *(const v4u*)pv;
                hl1[u] = p1[(s > 0) ? -1 : 0]; hr1[u] = p1[(s + 8 < SEQ) ? 8 : 7]; hlv[u] = pv[(s > 0) ? -1 : 0]; hrv[u] = pv[(s + 8 < SEQ) ? 8 : 7];
            }
#pragma unroll
            for (int u = 0; u < 4; ++u) {
                const int idx = ((itg & 1) * 4 + u) * 512 + tid, b = idx >> 7, sg = idx & 127, s = ch * 1024 + 8 * sg;
                const float l1 = (s > 0) ? bf2f(hl1[u]) : 0.f, r1 = (s + 8 < SEQ) ? bf2f(hr1[u]) : 0.f;
                const float lv = (s > 0) ? bf2f(hlv[u]) : 0.f, rv_ = (s + 8 < SEQ) ? bf2f(hrv[u]) : 0.f;
                float o1[8], ov[8];
                conv8(o1, c1[u], l1, r1, wx1_0, wx1_1, wx1_2, bx1);
                conv8(ov, cv[u], lv, rv_, wv_0, wv_1, wv_2, bv);
                v4u w; w.x = pk2(ov[0] * o1[0], ov[1] * o1[1]); w.y = pk2(ov[2] * o1[2], ov[3] * o1[3]); w.z = pk2(ov[4] * o1[4], ov[5] * o1[5]); w.w = pk2(ov[6] * o1[6], ov[7] * o1[7]);
                *(LAS v4u*)(lds + HY_VB + b * HY_VSTR + sg * 16) = w;
            }
        }
        __syncthreads();
        {
#pragma unroll
            for (int s_ = 0; s_ < 15; ++s_) fr[s_] = HY_LDA(16 * wave - 64 * ch + s_);
            fr[15] = HY_LDA(16 * wave - 64 * ch - 1);
        }
#pragma unroll 1
        for (int body = 0; body < 4; ++body) {
            const int kl0 = body * 16, kg0 = ch * 64 + kl0;
#pragma unroll
            for (int kk = 0; kk < 16; ++kk) {
                const bf16x8 bfrag = *(const LAS bf16x8*)(lds + bbase + 32 * (kl0 + kk));
#pragma unroll
                for (int i = 0; i < 8; ++i) acc[i] = __builtin_amdgcn_mfma_f32_32x32x16_bf16(fr[(2 * i - kk) & 15], bfrag, acc[i], 0, 0, 0);
                fr[(14 - kk) & 15] = HY_LDA(16 * wave - 2 - (kg0 + kk));
            }
        }
    }
#undef HY_LDA
    __syncthreads();
    LAS float* sc = (LAS float*)(lds + wave * HY_SCW);
#pragma unroll
    for (int hh = 0; hh < 2; ++hh) {
#pragma unroll
        for (int ii = 0; ii < 4; ++ii)
#pragma unroll
            for (int rr = 0; rr < 16; ++rr) sc[r * 132 + 32 * ii + crow(rr, h)] = acc[4 * hh + ii][rr];
        LDS_WAIT(); asm volatile("" ::: "memory");
#pragma unroll 1
        for (int itg = 0; itg < 4 * RPT_HY_EPI; ++itg) {
            v4u c0[2], c1[2], cv[2], cgt[2]; unsigned hl0[2], hr0[2], hl1[2], hr1[2], hlv[2], hrv[2];
#pragma unroll
            for (int u = 0; u < 2; ++u) {
                const int b = 4 * ((itg & 3) * 2 + u) + (lane >> 4), tg = lane & 15, t = 256 * wave + 128 * hh + 8 * tg;
                const size_t off = (size_t)b * SEQ + t;
                const bf16* p0 = x0row + off; const bf16* p1 = x1row + off; const bf16* pv = vrow + off;
                c0[u] = *(const v4u*)p0; c1[u] = *(const v4u*)p1; cv[u] = *(const v4u*)pv; cgt[u] = *(const v4u*)(grow + off);
                const int lo_ = (t > 0) ? -1 : 0, hi_ = (t + 8 < SEQ) ? 8 : 7;
                hl0[u] = p0[lo_]; hr0[u] = p0[hi_]; hl1[u] = p1[lo_]; hr1[u] = p1[hi_]; hlv[u] = pv[lo_]; hrv[u] = pv[hi_];
            }
#pragma unroll
            for (int u = 0; u < 2; ++u) {
                const int b = 4 * ((itg & 3) * 2 + u) + (lane >> 4), tg = lane & 15, t = 256 * wave + 128 * hh + 8 * tg;
                const size_t off = (size_t)b * SEQ + t;
                const f32x4 y0 = *(const LAS f32x4*)(sc + b * 132 + 8 * tg), y1 = *(const LAS f32x4*)(sc + b * 132 + 8 * tg + 4);
                const bool hasl = t > 0, hasr = (t + 8 < SEQ);
                const float l0 = hasl ? bf2f(hl0[u]) : 0.f, r0 = hasr ? bf2f(hr0[u]) : 0.f;
                const float l1 = hasl ? bf2f(hl1[u]) : 0.f, r1 = hasr ? bf2f(hr1[u]) : 0.f;
                const float lv = hasl ? bf2f(hlv[u]) : 0.f, rv_ = hasr ? bf2f(hrv[u]) : 0.f;
                float o0[8], o1[8], ov[8];
                conv8(o0, c0[u], l0, r0, wx0_0, wx0_1, wx0_2, bx0);
                conv8(o1, c1[u], l1, r1, wx1_0, wx1_1, wx1_2, bx1);
                conv8(ov, cv[u], lv, rv_, wv_0, wv_1, wv_2, bv);
                const float yv[8] = {y0[0], y0[1], y0[2], y0[3], y1[0], y1[1], y1[2], y1[3]};
                const v4u cg_ = cgt[u];
                const float gt[8] = {bflo(cg_.x), bfhi(cg_.x), bflo(cg_.y), bfhi(cg_.y), bflo(cg_.z), bfhi(cg_.z), bflo(cg_.w), bfhi(cg_.w)};
                float res[8];
#pragma unroll
                for (int j = 0; j < 8; ++j) { const float vv = ov[j] * o1[j]; res[j] = ((yv[j] + vv * dskip) * o0[j]) * gt[j]; }
                v4u w; w.x = pk2(res[0], res[1]); w.y = pk2(res[2], res[3]); w.z = pk2(res[4], res[5]); w.w = pk2(res[6], res[7]);
                *(v4u*)(F.YT() + (size_t)c * MTOK + off) = w;
            }
        }
        LDS_WAIT(); asm volatile("" ::: "memory");
    }
}

constexpr int AT_QB = 128, AT_KSTR = 144, AT_VSTR = 128, AT_ROWS = AT_QB + 2 * WIN;
constexpr int AT_KS = 0, AT_VS = AT_ROWS * AT_KSTR  , AT_SCR = AT_VS + AT_ROWS * AT_VSTR  , AT_OST = AT_SCR + 8 * 128  ;
constexpr int AT_UNITS = BATCH * 2 * (SEQ / AT_QB);
static_assert(AT_OST + 8 * 4096 <= LDS_BYTES - 64, "attention LDS map");

__device__ __forceinline__ s16x4 lds_tr(const LAS unsigned char* p) {
    typedef short v4i16_t __attribute__((ext_vector_type(4)));
    return __builtin_bit_cast(s16x4, __builtin_amdgcn_ds_read_tr16_b64_v4i16((LAS v4i16_t*)p));
}

__device__ __forceinline__ void attn_unit(Frame& F, int uidx) {
    int tid = F.tid; asm volatile("" : "+v"(tid));
    const int lane = tid & 63, wave = F.wave, r = lane & 31, h = lane >> 5;
    LAS unsigned char* lds = F.lds;
    const int qb = uidx & 15, kvh = (uidx >> 4) & 1, b = uidx >> 5;
    const int q0 = qb * AT_QB, kbase = q0 - WIN; const size_t rowbase = (size_t)b * SEQ;
    const int g = wave >> 1, hd = 4 * kvh + g;
    bf16x8 qfa[4], qfb[4];
    { const bf16* qp = F.ZA() + (rowbase + q0 + 64 * (wave & 1) + r) * NATC + 64 * hd + 8 * h;
#pragma unroll
      for (int d = 0; d < 4; ++d) { qfa[d] = *(const bf16x8*)(qp + 16 * d); qfb[d] = *(const bf16x8*)(qp + (size_t)32 * NATC + 16 * d); } }
    __syncthreads();
    {
        v4u kk[6], vv[6];
#pragma unroll
        for (int u = 0; u < 6; ++u) { const int p = tid + u * NTHREADS, row = p >> 3, pc = p & 7, key = kbase + row;
            kk[u] = (v4u){0u, 0u, 0u, 0u}; vv[u] = (v4u){0u, 0u, 0u, 0u};
            if (key >= 0 && key < SEQ) { const bf16* src = F.ZA() + (rowbase + key) * NATC + 512 + 64 * kvh + 8 * pc; kk[u] = *(const v4u*)src; vv[u] = *(const v4u*)(src + 128); } }
#pragma unroll
        for (int u = 0; u < 6; ++u) { const int p = tid + u * NTHREADS, row = p >> 3, pc = p & 7;
            *(LAS v4u*)(lds + AT_KS + row * AT_KSTR + pc * 16) = kk[u];
            *(LAS v4u*)(lds + AT_VS + row * AT_VSTR + (((pc >> 2) ^ ((row >> 1) & 1)) * 64) + (pc & 3) * 16) = vv[u]; }
    }
    __syncthreads();
    const float slope2 = exp2f(-(float)(hd + 1)) * LOG2E, sink2 = F.attn_sink()[hd] * LOG2E;
    float crel[16];
#pragma unroll
    for (int rr = 0; rr < 16; ++rr) { const int cr = crow(rr, h); crel[rr] = (float)(cr - r - WIN); }
    LAS float* wsf = (LAS float*)(lds + AT_SCR + wave * 128);
    LAS unsigned short* stg = (LAS unsigned short*)(lds + AT_OST + wave * 4096);
    const int vsw = (lane >> 3) & 1;
#pragma unroll
    for (int sb = 0; sb < 2; ++sb) {
        const int sub = 2 * (wave & 1) + sb, qs = q0 + 32 * sub;
        bf16x8 qf[4];
#pragma unroll
        for (int d = 0; d < 4; ++d) qf[d] = sb ? qfb[d] : qfa[d];
        const int jlo = (4 - (qs >> 5)) > 0 ? (4 - (qs >> 5)) : 0, jhi = (((SEQ - qs) >> 5) + 3) < 8 ? (((SEQ - qs) >> 5) + 3) : 8;
        const LAS unsigned char* kp = lds + AT_KS + (32 * sub + r) * AT_KSTR + 16 * h;
        const LAS unsigned char* vp0 = lds + AT_VS + (32 * sub + 4 * h + ((lane & 15) >> 2)) * AT_VSTR + (16 * ((lane >> 4) & 1) + 4 * (lane & 3)) * 2 + vsw * 64;
        const LAS unsigned char* vp1 = lds + AT_VS + (32 * sub + 4 * h + ((lane & 15) >> 2)) * AT_VSTR + (16 * ((lane >> 4) & 1) + 4 * (lane & 3)) * 2 + (vsw ^ 1) * 64;
        v4u gt4[4];
#pragma unroll
        for (int i = 0; i < 4; ++i) gt4[i] = *(const v4u*)(F.ZA() + (rowbase + qs + i * 8 + (lane >> 3)) * NATC + 768 + 64 * hd + 8 * (lane & 7));
#define AT_SCORES(S, j) do { S = f32x16{}; \
            _Pragma("unroll") for (int d = 0; d < 4; ++d) { const bf16x8 kf = *(const LAS bf16x8*)(kp + (j) * 32 * AT_KSTR + d * 32); S = __builtin_amdgcn_mfma_f32_32x32x16_bf16(kf, qf[d], S, 0, 0, 0); } \
            const float jo_ = (float)(32 * (j)); \
            _Pragma("unroll") for (int rr = 0; rr < 16; ++rr) S[rr] = S[rr] - slope2 * __builtin_fabsf(crel[rr] + jo_); \
            if ((j) == 0) { _Pragma("unroll") for (int rr = 0; rr < 16; ++rr) S[rr] = (crel[rr] >= -(float)WIN) ? S[rr] : -1e30f; } \
            if ((j) == 8) { _Pragma("unroll") for (int rr = 0; rr < 16; ++rr) S[rr] = (crel[rr] <= -(float)WIN) ? S[rr] : -1e30f; } } while (0)
        float mx = sink2;
#pragma unroll 1
        for (int j = jlo; j <= jhi; ++j) { f32x16 S; AT_SCORES(S, j);
#pragma unroll
            for (int rr = 0; rr < 16; ++rr) mx = fmaxf(mx, S[rr]); }
        mx = fmaxf(mx, __shfl_xor(mx, 32));
        float lsum = 0.f; f32x16 o0 = f32x16{}, o1 = f32x16{};
#pragma unroll 1
        for (int j = jlo; j <= jhi; ++j) { f32x16 S; AT_SCORES(S, j);
#pragma unroll
            for (int rr = 0; rr < 16; ++rr) { const float pexp = __builtin_amdgcn_exp2f(S[rr] - mx); S[rr] = pexp; lsum += pexp; }
#pragma unroll
            for (int ks = 0; ks < 2; ++ks) {
                v4u pw; pw.x = pk2(S[8 * ks + 0], S[8 * ks + 1]); pw.y = pk2(S[8 * ks + 2], S[8 * ks + 3]); pw.z = pk2(S[8 * ks + 4], S[8 * ks + 5]); pw.w = pk2(S[8 * ks + 6], S[8 * ks + 7]);
                const bf16x8 pf = __builtin_bit_cast(bf16x8, pw);
                const int vo = (j * 32 + 16 * ks) * AT_VSTR;
                { const s16x4 lo = lds_tr(vp0 + vo), hi4 = lds_tr(vp0 + vo + 8 * AT_VSTR);
                  const bf16x8 vf = (bf16x8){lo[0], lo[1], lo[2], lo[3], hi4[0], hi4[1], hi4[2], hi4[3]};
                  o0 = __builtin_amdgcn_mfma_f32_32x32x16_bf16(pf, vf, o0, 0, 0, 0); }
                { const s16x4 lo = lds_tr(vp1 + vo), hi4 = lds_tr(vp1 + vo + 8 * AT_VSTR);
                  const bf16x8 vf = (bf16x8){lo[0], lo[1], lo[2], lo[3], hi4[0], hi4[1], hi4[2], hi4[3]};
                  o1 = __builtin_amdgcn_mfma_f32_32x32x16_bf16(pf, vf, o1, 0, 0, 0); }
            }
        }
#undef AT_SCORES
        lsum += __shfl_xor(lsum, 32);
        lsum += __builtin_amdgcn_exp2f(sink2 - mx);
        if (h == 0) wsf[r] = 1.0f / lsum;
        LDS_WAIT(); asm volatile("" ::: "memory");
#pragma unroll
        for (int rr = 0; rr < 16; ++rr) { const int ql = crow(rr, h); const float inv = wsf[ql];
            stg[ql * 64 + r] = (unsigned short)f2bf(o0[rr] * inv); stg[ql * 64 + 32 + r] = (unsigned short)f2bf(o1[rr] * inv); }
        LDS_WAIT(); asm volatile("" ::: "memory");
#pragma unroll
        for (int i = 0; i < 4; ++i) { const int row = i * 8 + (lane >> 3), ch = lane & 7;
            const v4u ov = *(const LAS v4u*)(stg + row * 64 + ch * 8); const v4u gv = gt4[i];
            v4u w; w.x = pk2(bflo(ov.x) * bflo(gv.x), bfhi(ov.x) * bfhi(gv.x)); w.y = pk2(bflo(ov.y) * bflo(gv.y), bfhi(ov.y) * bfhi(gv.y));
            w.z = pk2(bflo(ov.z) * bflo(gv.z), bfhi(ov.z) * bfhi(gv.z)); w.w = pk2(bflo(ov.w) * bflo(gv.w), bfhi(ov.w) * bfhi(gv.w));
            *(v4u*)(F.YMIX() + (rowbase + qs + row) * DMODEL + DHY + 64 * hd + 8 * ch) = w; }
        LDS_WAIT(); asm volatile("" ::: "memory");
    }
}

__device__ __forceinline__ void p3_panel(Frame& F, int pm) {
    int tid = F.tid, lane = F.lane; const int wave = F.wave;
    asm volatile("" : "+v"(tid), "+v"(lane));
#ifndef P3_NO_A
    for (int rp_ = 0; rp_ < RPT_P3_A; ++rp_) {
        const int ml = tid & 255, half = tid >> 8;
        const size_t m = (size_t)pm * 256 + ml;
#pragma unroll 4
        for (int oc = half * 32; oc < half * 32 + 32; ++oc) {
            const bf16* src = F.YT() + (size_t)(8 * oc) * MTOK + m;
            unsigned e[8];
#pragma unroll
            for (int i = 0; i < 8; ++i) e[i] = src[(size_t)i * MTOK];
            v4u w; w.x = e[0] | (e[1] << 16); w.y = e[2] | (e[3] << 16); w.z = e[4] | (e[5] << 16); w.w = e[6] | (e[7] << 16);
            *(v4u*)(F.YMIX() + m * DMODEL + 8 * oc) = w;
        }
    }
#endif
    VM_WAIT(); __syncthreads();
    {
        const bf16* w2 = F.W2T(); const bf16* ym = F.YMIX();
        asm volatile("" : "+s"(w2), "+s"(ym));
        pg8::Gemm g{ym, w2, MTOK, DMODEL, DMODEL}; pg8::PanelOrder S{pm, DMODEL / 256};
        pg8::EpiY E{F.YRAW(), DMODEL, F.SS()};
        pg8::gemm_phase<pg8::EpiY, pg8::PanelOrder, true, true>(F.lds, g, S, E);
    }
    VM_WAIT(); __syncthreads();
    asm volatile("" : "+v"(lane));
#ifndef P3_NO_C
    for (int rp_ = 0; rp_ < RPT_P3_C; ++rp_) {
        f32x4 gq[4];
#pragma unroll
        for (int j = 0; j < 4; ++j) gq[j] = *((const f32x4*)F.post_g() + lane + 64 * j);
#pragma unroll 1
        for (int i = 0; i < 32; i += 4) {
            const size_t row0 = (size_t)pm * 256 + wave * 32 + i;
            float ss[4]; v2u yw[4][4]; f32x4 xv[4][4];
#pragma unroll
            for (int q = 0; q < 4; ++q) { const size_t row = row0 + q;
                ss[q] = (lane < 16) ? F.SS()[row * 16 + lane] : 0.f;
                const v2u* yr = (const v2u*)(F.YRAW() + row * DMODEL) + lane; const f32x4* xr = (const f32x4*)(F.x() + row * DMODEL) + lane;
#pragma unroll
                for (int j = 0; j < 4; ++j) { yw[q][j] = yr[64 * j]; xv[q][j] = xr[64 * j]; } }
#pragma unroll
            for (int o = 1; o < 16; o <<= 1) {
#pragma unroll
                for (int q = 0; q < 4; ++q) ss[q] += __shfl_xor(ss[q], o); }
#pragma unroll
            for (int q = 0; q < 4; ++q) { const float tot = __shfl(ss[q], 0); const float rstd = 1.0f / sqrtf(tot * (1.0f / DMODEL) + RMS_EPS);
                f32x4* orow = (f32x4*)(F.out() + (row0 + q) * DMODEL) + lane;
#pragma unroll
                for (int j = 0; j < 4; ++j) { const v2u y = yw[q][j]; const f32x4 x = xv[q][j];
                    f32x4 o; o.x = x.x + bflo(y.x) * rstd * gq[j].x; o.y = x.y + bfhi(y.x) * rstd * gq[j].y; o.z = x.z + bflo(y.y) * rstd * gq[j].z; o.w = x.w + bfhi(y.y) * rstd * gq[j].w;
                    orow[64 * j] = o; } }
        }
    }
#endif
    __syncthreads();
}

typedef __attribute__((address_space(1))) unsigned gu32;
constexpr size_t WS_CTL = 0, CTL_ZERO_BYTES = 65536;
constexpr int MISC_OFF = LDS_BYTES - 64;
#define XB_TMO      128
#define XB_XCNT(j)  (256  + 64 * (j))
#define XB_XSUB(j)  (1280 + 64 * (j))
#define XB_XGEN(j)  (2304 + 64 * (j))
#define XB_TOP      3328
#define XB_TOPGEN   3392
#define XCD_BAR_WORDS 3456
#define XB_SPIN_CAP (1u << 18)

__device__ __forceinline__ unsigned xb_ld(unsigned* p)              { return __hip_atomic_load(p, __ATOMIC_RELAXED, __HIP_MEMORY_SCOPE_AGENT); }
__device__ __forceinline__ unsigned xb_add(unsigned* p, unsigned v) { return __hip_atomic_fetch_add(p, v, __ATOMIC_RELAXED, __HIP_MEMORY_SCOPE_AGENT); }
__device__ __forceinline__ unsigned xb_xcc_id() { return (unsigned)__builtin_amdgcn_s_getreg((3 << 11) | 20) & 0xFu; }
#define XB_SPIN(cond, bar) do { unsigned _sp = 0; while (cond) { __builtin_amdgcn_s_sleep(1); \
    if ((++_sp & 255u) == 0u) { if (xb_ld(&(bar)[XB_TMO])) break; if (_sp > XB_SPIN_CAP) { atomicAdd(&(bar)[XB_TMO], 1u); break; } } } } while (0)

struct XcdBarrier {
    unsigned* bar; unsigned x;
    volatile LAS unsigned* st;
};

__device__ __forceinline__ XcdBarrier xcd_barrier_post(unsigned* bar, volatile LAS unsigned* st) {
    XcdBarrier b; b.bar = bar; b.x = xb_xcc_id(); b.st = st;
    if (threadIdx.x == 0) (void)xb_add(&bar[XB_XCNT(b.x)], 1u);
    return b;
}
__device__ __forceinline__ void xcd_barrier_complete(unsigned* bar, unsigned x, unsigned& nloc, unsigned& nx) {
    const unsigned G = gridDim.x * gridDim.y * gridDim.z;
    unsigned sum, cnt, mine, sp = 0u;
    for (;;) {
        sum = 0u; cnt = 0u; mine = 0u;
#pragma unroll
        for (unsigned j = 0; j < 16; ++j) { const unsigned c = xb_ld(&bar[XB_XCNT(j)]); sum += c; cnt += (c > 0u) ? 1u : 0u; mine = (j == x) ? c : mine; }
        if (sum == G) break;
        __builtin_amdgcn_s_sleep(1);
        if ((++sp & 255u) == 0u) { if (xb_ld(&bar[XB_TMO])) break; if (sp > XB_SPIN_CAP) { atomicAdd(&bar[XB_TMO], 1u); break; } }
    }
    nloc = mine > 0u ? mine : 1u; nx = cnt > 0u ? cnt : 1u;
}

__device__ __forceinline__ void xcd_barrier(const XcdBarrier& b) {
    asm volatile("s_waitcnt vmcnt(0)" ::: "memory");
    __syncthreads();
    if (threadIdx.x == 0) {
        unsigned* bar = b.bar;
        __builtin_amdgcn_s_waitcnt(0);
        unsigned nloc = b.st[0], nx = b.st[1];
        if (nloc == 0u) { xcd_barrier_complete(bar, b.x, nloc, nx); b.st[0] = nloc; b.st[1] = nx; }
        const unsigned old = xb_add(&bar[XB_XSUB(b.x)], 1u);
        const unsigned gen = old / nloc;
        if (old + 1u == (gen + 1u) * nloc) {
            __builtin_amdgcn_fence(__ATOMIC_RELEASE, "agent");
            asm volatile("s_waitcnt vmcnt(0)" ::: "memory");
            const unsigned og = xb_add(&bar[XB_TOP], 1u);
            const unsigned tg = og / nx;
            if (og + 1u == (tg + 1u) * nx) xb_add(&bar[XB_TOPGEN], 1u);
            else XB_SPIN(xb_ld(&bar[XB_TOPGEN]) == tg, bar);
            __builtin_amdgcn_fence(__ATOMIC_ACQUIRE, "agent");
            xb_add(&bar[XB_XGEN(b.x)], 1u);
            asm volatile("s_waitcnt vmcnt(0)" ::: "memory");
        } else {
            XB_SPIN(xb_ld(&bar[XB_XGEN(b.x)]) == gen, bar);
            __builtin_amdgcn_fence(__ATOMIC_ACQUIRE, "agent");
            asm volatile("s_waitcnt vmcnt(0)" ::: "memory");
        }
    }
    __syncthreads();
}

__global__ void __launch_bounds__(NTHREADS, 2) hybrid_fwd(Args args) {
    extern __shared__ __attribute__((aligned(16))) unsigned char lds_raw[];
    Frame F;
    F.lds = (LAS unsigned char*)lds_raw;
    F.tid = threadIdx.x; F.lane = F.tid & 63; F.wave = __builtin_amdgcn_readfirstlane(F.tid >> 6);
    F.G = gridDim.x; { const int bx = blockIdx.x; F.vcu = (F.G % 8 == 0) ? (bx % 8) * (F.G / 8) + bx / 8 : bx; }
    F.A = &args;
    const int lo = args.ph_lo, hi = args.ph_hi;
#if MK_XCD_BARRIER
    if (F.tid < 16) ((volatile LAS unsigned*)(F.lds + MISC_OFF))[F.tid] = 0u;
    __syncthreads();
    XcdBarrier bar = xcd_barrier_post((unsigned*)(args.ws + WS_CTL), (volatile LAS unsigned*)(F.lds + MISC_OFF));
#endif
#define IN(k) (lo <= (k) && (k) < hi)
#if MK_XCD_BARRIER
#define SEAM(k) do { if (IN(k) && IN((k) + 1)) { xcd_barrier(bar); } } while (0)
#else
#define SEAM(k) do { if (IN(k) && IN((k) + 1)) { cg::this_grid().sync(); } } while (0)
#endif

#ifndef NO_P0
    if (IN(0)) { for (int rp_ = 0; rp_ < RPT_P0; ++rp_) p0_prologue(F); }
#endif
    SEAM(0);
#ifndef NO_P1
    if (IN(1)) for (int rp_ = 0; rp_ < RPT_P1; ++rp_) {
        { pg8::Gemm g{F.W1T(), F.XN(), NHYC, MTOK, DMODEL}; pg8::StaticOrder S; S.init(NHYC, MTOK, F.G, (int)blockIdx.x);
          pg8::EpiZT E{F.ZT(), MTOK};
          pg8::gemm_phase<pg8::EpiZT, pg8::StaticOrder, true, true>(F.lds, g, S, E); }
        { pg8::Gemm g{F.XN(), F.W1T() + (size_t)NHYC * DMODEL, MTOK, NATC, DMODEL}; pg8::StaticOrder S; S.init(MTOK, NATC, F.G, (int)blockIdx.x);
          pg8::EpiZA E{F.ZA(), NATC, QSCALE};
          pg8::gemm_phase<pg8::EpiZA, pg8::StaticOrder, true, true>(F.lds, g, S, E); }
    }
#endif
    SEAM(1);
    if (IN(2)) {
#ifndef NO_HY
        for (int rp_ = 0; rp_ < RPT_HY; ++rp_) for (int c = F.vcu; c < DHY; c += F.G) hyena_unit(F, c);
#endif
        const int nau = AT_UNITS, per = (nau + F.G - 1) / F.G;
#ifndef NO_AT
        for (int rp_ = 0; rp_ < RPT_AT; ++rp_) for (int i = 0; i < per; ++i) { const int u = F.vcu * per + i; if (u < nau) attn_unit(F, u); }
#endif
    }
    SEAM(2);
    if (IN(3)) {
#ifndef NO_P3
        for (int rp_ = 0; rp_ < RPT_P3; ++rp_) for (int pm = F.vcu; pm < MTOK / 256; pm += F.G) p3_panel(F, pm);
#endif
    }
#undef IN
#undef SEAM
}

extern "C" void kernel_launch(void* const* d_in, const int* in_sizes, int n_in, void* d_out, int out_size, void* d_ws, size_t ws_size, hipStream_t stream) {
    static int grid = 0;
    if (grid == 0) {
        if (n_in != 17 || in_sizes[0] != MTOK * DMODEL || out_size != MTOK * DMODEL || ws_size < WS_END) {
            fprintf(stderr, "kernel_launch: unexpected shapes (n_in %d, in0 %d, out %d, ws %zu); nothing launched\n", n_in, n_in > 0 ? in_sizes[0] : -1, out_size, ws_size); grid = -1; return; }
        int dev = 0, cus = 0, per_cu = 0;
        if (hipGetDevice(&dev) != hipSuccess || hipDeviceGetAttribute(&cus, hipDeviceAttributeMultiprocessorCount, dev) != hipSuccess) { fprintf(stderr, "kernel_launch: device query failed\n"); grid = -1; return; }
        if (hipFuncSetAttribute((const void*)hybrid_fwd, hipFuncAttributeMaxDynamicSharedMemorySize, LDS_BYTES) != hipSuccess) { fprintf(stderr, "kernel_launch: hipFuncSetAttribute failed\n"); grid = -1; return; }
        if (hipOccupancyMaxActiveBlocksPerMultiprocessor(&per_cu, (const void*)hybrid_fwd, NTHREADS, LDS_BYTES) != hipSuccess || per_cu < 1) {
            fprintf(stderr, "kernel_launch: occupancy query reports %d workgroups per CU; nothing launched\n", per_cu); (void)hipGetLastError(); grid = -1; return; }
        grid = cus;
    }
    if (grid < 0) return;
    Args a{};
    for (int i = 0; i < 17; ++i) a.in[i] = (const float*)d_in[i];
    a.out = (float*)d_out; a.ws = (unsigned char*)d_ws;
#if MK_N_LAUNCHES == 1
    a.ph_lo = 0; a.ph_hi = 4;
#if MK_XCD_BARRIER
    if (hipMemsetAsync((char*)d_ws + WS_CTL, 0, CTL_ZERO_BYTES, stream) != hipSuccess) { fprintf(stderr, "kernel_launch: hipMemsetAsync failed\n"); return; }
#endif
#if MK_COOP
    void* kargs[] = {&a};
    const hipError_t e = hipLaunchCooperativeKernel((const void*)hybrid_fwd, dim3(grid), dim3(NTHREADS), kargs, LDS_BYTES, stream);
    if (e != hipSuccess) fprintf(stderr, "kernel_launch: cooperative launch failed: %s (grid %d)\n", hipGetErrorString(e), grid);
#else
    hipLaunchKernelGGL(hybrid_fwd, dim3(grid), dim3(NTHREADS), LDS_BYTES, stream, a);
#endif
#else
    for (int p = 0; p < 4; ++p) {
        a.ph_lo = p; a.ph_hi = p + 1;
        hipLaunchKernelGGL(hybrid_fwd, dim3(grid), dim3(NTHREADS), LDS_BYTES, stream, a);
        const hipError_t le = hipPeekAtLastError();
        if (le != hipSuccess) { fprintf(stderr, "kernel_launch: launch %d failed: %s\n", p, hipGetErrorName(le)); break; }
    }
#endif
}
```
